# Optimizing an MI355X kernel written in HIP

```python
import jax, jax.numpy as jnp
from jax import lax
import numpy as np

D_MODEL = 4096
BATCH = 2
SEQ = 8192
DEPTH = 1

MEM_LEN = 256
D_FF = 11008
POOL_WINDOWS = (2, 4, 8, 16)
N_POOL_GROUPS = len(POOL_WINDOWS)
POOL_GROUP = D_MODEL // 8
POOL_WIDTH = POOL_GROUP * N_POOL_GROUPS
MLA_HEADS = D_MODEL // 256
Q_LORA = D_MODEL // 4
KV_LORA = 512
QK_NOPE = 128
QK_ROPE = 64
V_HEAD = 128
QK_HEAD = QK_NOPE + QK_ROPE
MLA_WIDTH = MLA_HEADS * V_HEAD
X_HEADS = 4
X_HEAD_DIM = 128
X_WIDTH = X_HEADS * X_HEAD_DIM
ROPE_THETA = 10000.0
EPS = 1e-6
Q_BLOCK = 128
IN_SPLITS = (POOL_WIDTH, Q_LORA, KV_LORA, QK_ROPE, D_MODEL, D_MODEL)
IN_WIDTH = sum(IN_SPLITS)

kernel_name = "hybrid_pool_mla_macaron_block"


def rmsnorm(x, g):
    xf = x.astype(jnp.float32)
    y = xf * lax.rsqrt(jnp.mean(xf * xf, axis=-1, keepdims=True) + EPS)
    return (y * g.astype(jnp.float32)).astype(x.dtype)


def rope_tables(positions):
    half = QK_ROPE // 2
    inv = 1.0 / (ROPE_THETA ** (jnp.arange(half, dtype=jnp.float32) * (2.0 / QK_ROPE)))
    ang = positions.astype(jnp.float32)[:, :, None] * inv[None, None, :]
    return jnp.cos(ang)[:, :, None, :], jnp.sin(ang)[:, :, None, :]


def apply_rope(x, cos, sin):
    x1, x2 = jnp.split(x.astype(jnp.float32), 2, axis=-1)
    return jnp.concatenate([x1 * cos - x2 * sin, x2 * cos + x1 * sin], axis=-1).astype(x.dtype)


def swiglu(x, w_gu, w_down):
    g, u = jnp.split(x @ w_gu, 2, axis=-1)
    return (jax.nn.silu(g) * u) @ w_down


def causal_multiscale_pool(p, w_pool, pool_scale):
    B, S, _ = p.shape
    t = jnp.arange(S)
    outs = []
    for g, w in zip(jnp.split(p.astype(jnp.float32), N_POOL_GROUPS, axis=-1), POOL_WINDOWS):
        c = jnp.cumsum(g, axis=1)
        c_lag = jnp.pad(c, ((0, 0), (w, 0), (0, 0)))[:, :S]
        cnt = jnp.minimum(t + 1, w).astype(jnp.float32)[None, :, None]
        outs.append((c - c_lag) / cnt - g)
    mixed = jnp.stack(outs, axis=2).astype(p.dtype)
    mixed = jnp.einsum('bsgc,gcd->bsgd', mixed, w_pool)
    return mixed.reshape(B, S, POOL_WIDTH) * pool_scale


def causal_attention(q, k, v):
    B, H, S, Dk = q.shape
    nb = S // Q_BLOCK
    qb = q.reshape(B, H, nb, Q_BLOCK, Dk).transpose(2, 0, 1, 3, 4)
    kpos = jnp.arange(S)
    scale = Dk ** -0.5

    def one_block(args):
        qi, i = args
        s = jnp.einsum('bhqd,bhkd->bhqk', qi, k).astype(jnp.float32) * scale
        qpos = i * Q_BLOCK + jnp.arange(Q_BLOCK)
        s = jnp.where(kpos[None, :] <= qpos[:, None], s, -jnp.inf)
        pr = jax.nn.softmax(s, axis=-1).astype(v.dtype)
        return jnp.einsum('bhqk,bhkd->bhqd', pr, v)

    out = lax.map(one_block, (qb, jnp.arange(nb)))
    return out.transpose(1, 2, 0, 3, 4).reshape(B, H, S, v.shape[-1])


def setup_inputs(seed: int = 0) -> dict:
    key = jax.random.key(seed)
    ks = iter(jax.random.split(key, 40))

    def w(shape, fan_in):
        return jax.random.normal(next(ks), shape, jnp.float32) * (fan_in ** -0.5)

    def gain(n):
        return 1.0 + 0.02 * jax.random.normal(next(ks), (DEPTH, n), jnp.float32)

    L = DEPTH
    x = jax.random.normal(next(ks), (BATCH, SEQ, D_MODEL), jnp.float32)
    mem = jax.random.normal(next(ks), (BATCH, MEM_LEN, D_MODEL), jnp.float32)
    offset = jax.random.randint(next(ks), (BATCH, 1), 0, 1024, dtype=jnp.int32)
    positions = offset + jnp.arange(SEQ, dtype=jnp.int32)[None, :]
    return {
        "x": x, "mem": mem, "positions": positions,
        "ffn1_norm": gain(D_MODEL),
        "ffn1_w_gu": w((L, D_MODEL, 2 * D_FF), D_MODEL),
        "ffn1_w_down": w((L, D_FF, D_MODEL), D_FF),
        "mix_norm": gain(D_MODEL),
        "w_in": w((L, D_MODEL, IN_WIDTH), D_MODEL),
        "w_pool": w((L, N_POOL_GROUPS, POOL_GROUP, POOL_GROUP), POOL_GROUP),
        "pool_scale": gain(POOL_WIDTH),
        "q_latent_norm": gain(Q_LORA),
        "kv_latent_norm": gain(KV_LORA),
        "w_uq": w((L, Q_LORA, MLA_HEADS * QK_HEAD), Q_LORA),
        "w_ukv": w((L, KV_LORA, MLA_HEADS * (QK_NOPE + V_HEAD)), KV_LORA),
        "q_nope_norm": gain(QK_NOPE),
        "k_nope_norm": gain(QK_NOPE),
        "q_rope_norm": gain(QK_ROPE),
        "k_rope_norm": gain(QK_ROPE),
        "w_branch_pool": w((L, POOL_WIDTH, D_MODEL), POOL_WIDTH),
        "w_branch_mla": w((L, MLA_WIDTH, D_MODEL), MLA_WIDTH),
        "w_out": w((L, D_MODEL, D_MODEL), D_MODEL),
        "x_norm": gain(D_MODEL),
        "mem_norm": gain(D_MODEL),
        "w_xq": w((L, D_MODEL, X_WIDTH), D_MODEL),
        "w_xkv": w((L, D_MODEL, 2 * X_WIDTH), D_MODEL),
        "xq_norm": gain(X_HEAD_DIM),
        "xk_norm": gain(X_HEAD_DIM),
        "w_xo": w((L, X_WIDTH, D_MODEL), X_WIDTH),
        "ffn2_norm": gain(D_MODEL),
        "ffn2_w_gu": w((L, D_MODEL, 2 * D_FF), D_MODEL),
        "ffn2_w_down": w((L, D_FF, D_MODEL), D_FF),
    }


def reference(x, mem, positions, ffn1_norm, ffn1_w_gu, ffn1_w_down, mix_norm, w_in, w_pool,
              pool_scale, q_latent_norm, kv_latent_norm, w_uq, w_ukv, q_nope_norm, k_nope_norm,
              q_rope_norm, k_rope_norm, w_branch_pool, w_branch_mla, w_out, x_norm, mem_norm,
              w_xq, w_xkv, xq_norm, xk_norm, w_xo, ffn2_norm, ffn2_w_gu, ffn2_w_down):
    B, S, _ = x.shape
    M = mem.shape[1]
    cos, sin = rope_tables(positions)
    split_idx = [int(v) for v in np.cumsum(IN_SPLITS)[:-1]]
    h = x
    for l in range(DEPTH):
        h = h + 0.5 * swiglu(rmsnorm(h, ffn1_norm[l]), ffn1_w_gu[l], ffn1_w_down[l])

        u = rmsnorm(h, mix_norm[l])
        z_pool, z_q, z_kv, z_kr, g_pool, g_mla = jnp.split(u @ w_in[l], split_idx, axis=-1)

        a_out = causal_multiscale_pool(z_pool, w_pool[l], pool_scale[l])

        c_q = rmsnorm(z_q, q_latent_norm[l])
        q = (c_q @ w_uq[l]).reshape(B, S, MLA_HEADS, QK_HEAD)
        q_nope = rmsnorm(q[..., :QK_NOPE], q_nope_norm[l])
        q_rope = apply_rope(rmsnorm(q[..., QK_NOPE:], q_rope_norm[l]), cos, sin)
        c_kv = rmsnorm(z_kv, kv_latent_norm[l])
        kv = (c_kv @ w_ukv[l]).reshape(B, S, MLA_HEADS, QK_NOPE + V_HEAD)
        k_nope = rmsnorm(kv[..., :QK_NOPE], k_nope_norm[l])
        v = kv[..., QK_NOPE:]
        k_rope = apply_rope(rmsnorm(z_kr, k_rope_norm[l])[:, :, None, :], cos, sin)
        q_full = jnp.concatenate([q_nope, q_rope], axis=-1)
        k_full = jnp.concatenate([k_nope, jnp.broadcast_to(k_rope, (B, S, MLA_HEADS, QK_ROPE))], axis=-1)
        attn = causal_attention(q_full.transpose(0, 2, 1, 3), k_full.transpose(0, 2, 1, 3),
                                v.transpose(0, 2, 1, 3))
        b_out = attn.transpose(0, 2, 1, 3).reshape(B, S, MLA_WIDTH)

        merged = (jax.nn.sigmoid(g_pool) * (a_out @ w_branch_pool[l])
                  + jax.nn.sigmoid(g_mla) * (b_out @ w_branch_mla[l]))
        h = h + merged @ w_out[l]

        uq = rmsnorm(h, x_norm[l])
        mn = rmsnorm(mem, mem_norm[l])
        xq = rmsnorm((uq @ w_xq[l]).reshape(B, S, X_HEADS, X_HEAD_DIM), xq_norm[l])
        xk, xv = jnp.split(mn @ w_xkv[l], 2, axis=-1)
        xk = rmsnorm(xk.reshape(B, M, X_HEADS, X_HEAD_DIM), xk_norm[l])
        xv = xv.reshape(B, M, X_HEADS, X_HEAD_DIM)
        s = jnp.einsum('bshd,bmhd->bhsm', xq, xk).astype(jnp.float32) * (X_HEAD_DIM ** -0.5)
        pr = jax.nn.softmax(s, axis=-1).astype(xv.dtype)
        xo = jnp.einsum('bhsm,bmhd->bshd', pr, xv).reshape(B, S, X_WIDTH)
        h = h + xo @ w_xo[l]

        h = h + 0.5 * swiglu(rmsnorm(h, ffn2_norm[l]), ffn2_w_gu[l], ffn2_w_down[l])
    return h
```

```cpp
#include <hip/hip_runtime.h>
#include <cstdio>
#include <cstdint>

#ifndef MK_ONE_LAUNCH
#define MK_ONE_LAUNCH 1
#endif

#define LAS __attribute__((address_space(3)))
#define GAS __attribute__((address_space(1)))
typedef unsigned short bf16_t;
typedef short bf16x8 __attribute__((ext_vector_type(8)));
typedef short s16x4 __attribute__((ext_vector_type(4)));
typedef float f32x2 __attribute__((ext_vector_type(2)));
typedef float f32x4 __attribute__((ext_vector_type(4)));
typedef float f32x16 __attribute__((ext_vector_type(16)));
typedef unsigned u32x2 __attribute__((ext_vector_type(2)));
typedef unsigned u32x4 __attribute__((ext_vector_type(4)));

constexpr int D = 4096, SEQ = 8192, M = 16384, MMEM = 512, FF = 11008;
constexpr int ZW = 12032;
constexpr int Z_ZP = 0, Z_ZQ = 2048, Z_ZKV = 3072, Z_GP = 3584, Z_GM = 7680, Z_KR = 11776;
constexpr int NH = 16, QW = 3072, KVW = 4096, AW = 2048;
constexpr float EPS = 1e-6f;
constexpr float LOG2E = 1.4426950408889634f;
constexpr float QSCALE = 0.07216878364870323f * LOG2E;
constexpr float XSCALE = 0.08838834764831845f * LOG2E;

constexpr size_t MiB = 1u << 20;
constexpr size_t WS_CTL = 0, CTL_ZERO_BYTES = 1 * MiB;
constexpr size_t WS_WGU = 1 * MiB, WS_WDN = 173 * MiB, WS_WIN = 259 * MiB, WS_WPOOL = 353 * MiB, WS_WUQ = 355 * MiB, WS_WUKV = 361 * MiB,
                 WS_WBP = 365 * MiB, WS_WBM = 381 * MiB, WS_WOUT = 397 * MiB, WS_WXQ = 429 * MiB, WS_WXKV = 433 * MiB, WS_WXO = 441 * MiB;
constexpr size_t WS_XN = 445 * MiB, WS_MN = 573 * MiB, WS_XKV = 577 * MiB, WS_XKB = 579 * MiB, WS_XVB = 579 * MiB + 512 * 1024;
constexpr size_t WS_R = 580 * MiB;
constexpr size_t WS_HID = WS_R, WS_Z = WS_R, WS_CQ = WS_R + 376 * MiB, WS_CKV = WS_R + 408 * MiB, WS_KR = WS_R + 424 * MiB, WS_PM = WS_R + 426 * MiB,
                 WS_Q = WS_R + 490 * MiB, WS_KV = WS_R + 586 * MiB, WS_AO = WS_R + 714 * MiB, WS_BO = WS_R + 778 * MiB, WS_END = WS_R + 842 * MiB;
constexpr size_t WS_XQP = WS_R, WS_XO = WS_R + 64 * MiB;
constexpr int CW_BAR = 4096;

constexpr int RING_BYTES = 131072, LDSCTL_OFF = RING_BYTES, MISC_OFF = LDSCTL_OFF + 320, LDS_BYTES = 147456;

__device__ __forceinline__ unsigned cvt_pk_bf16(float lo, float hi) { unsigned r; asm volatile("v_cvt_pk_bf16_f32 %0, %1, %2" : "=v"(r) : "v"(lo), "v"(hi)); return r; }
__device__ __forceinline__ float bf_lo(unsigned u) { return __builtin_bit_cast(float, u << 16); }
__device__ __forceinline__ float bf_hi(unsigned u) { return __builtin_bit_cast(float, u & 0xffff0000u); }
__device__ __forceinline__ float sigmoidf_(float x) { return __builtin_amdgcn_rcpf(1.0f + __builtin_amdgcn_exp2f(-x * LOG2E)); }

namespace pg8 {
constexpr int BM = 256, BK = 64, HALF = 128, HTB = HALF * BK * 2, STAGE_BYTES = 8 * HTB, NXCD = 8, WGM = 8;
__host__ __device__ __forceinline__ int lds_byte(int r, int c) { const int st = (r >> 4) * 2 + (c >> 5), rr = r & 15, cc = c & 31, ob = rr * 64 + cc * 2; return st * 1024 + (ob ^ (((ob >> 9) & 1) << 5)); }
__host__ __device__ __forceinline__ void stage_rc(int b, int& R, int& C) { const int st = b / 1024, sb = b % 1024, swz = sb ^ (((sb >> 9) & 1) << 5); R = (st >> 1) * 16 + swz / 64; C = (st & 1) * 32 + (swz % 64) / 2; }
__host__ __device__ __forceinline__ int perm32(int rho) { const int n = rho >> 4, i = rho & 15; return 8 * (i >> 2) + 4 * n + (i & 3); }

struct Unit { int pm, pn; };
struct Gemm { const bf16_t* A; const bf16_t* Bt; int lda, ldb, K; int ashift, astride, bmask, bstride; };
__device__ __forceinline__ Gemm mk_gemm(const bf16_t* A, const bf16_t* Bt, int lda, int ldb, int K) { Gemm g; g.A = A; g.Bt = Bt; g.lda = lda; g.ldb = ldb; g.K = K; g.ashift = 30; g.astride = 0; g.bmask = 0x7fffffff; g.bstride = 0; return g; }

struct StaticOrder {
    int nM, nN, nwg, G, c;
    __host__ __device__ void init(int nM_, int nN_, int G_, int c_) { nM = nM_; nN = nN_; nwg = nM * nN; G = G_; c = c_; }
    __host__ __device__ bool next(int i, Unit& u) const {
        const long L = (long)i * G + c; if (L >= nwg) return false;
        int wgid = (int)L; { const int q = nwg / NXCD, r = nwg % NXCD, xcd = wgid % NXCD, off = wgid / NXCD; wgid = (xcd < r ? xcd * (q + 1) : r * (q + 1) + (xcd - r) * q) + off; }
        const int nig = WGM * nN, gid = wgid / nig, fm = gid * WGM, gsz = (nM - fm) < WGM ? (nM - fm) : WGM;
        u.pm = fm + ((wgid % nig) % gsz); u.pn = (wgid % nig) / gsz; return true;
    }
};

struct EpiSwiGLU {
    static constexpr bool PERM = true;
    bf16_t* H; int ldh;
    __device__ __forceinline__ void operator()(const f32x4 (&acc)[2][2][4][2], const Unit& u, int wr, int wc, int fr, int fq) const {
        const int row0 = u.pm * BM + wr * 64 + fr, col0 = u.pn * HALF + wc * 32 + 8 * fq;
#pragma unroll
        for (int ai = 0; ai < 2; ++ai)
#pragma unroll
            for (int m = 0; m < 4; ++m) {
                float h[8];
#pragma unroll
                for (int n = 0; n < 2; ++n)
#pragma unroll
                    for (int e = 0; e < 4; ++e) { const float g = acc[ai][0][m][n][e], up = acc[ai][1][m][n][e]; h[n * 4 + e] = g * sigmoidf_(g) * up; }
                u32x4 w; w.x = cvt_pk_bf16(h[0], h[1]); w.y = cvt_pk_bf16(h[2], h[3]); w.z = cvt_pk_bf16(h[4], h[5]); w.w = cvt_pk_bf16(h[6], h[7]);
                *(u32x4*)(H + (size_t)(row0 + ai * HALF + m * 16) * ldh + col0) = w; }
    }
};
struct EpiResF32 {
    static constexpr bool PERM = false;
    const float* base; float* out; int ldc; float alpha;
    __device__ __forceinline__ void operator()(const f32x4 (&acc)[2][2][4][2], const Unit& u, int wr, int wc, int fr, int fq) const {
        const int row0 = u.pm * BM + wr * 64 + fr, col0 = u.pn * BM + wc * 32 + 4 * fq;
#pragma unroll
        for (int ai = 0; ai < 2; ++ai)
#pragma unroll
            for (int m = 0; m < 4; ++m) { const size_t off = (size_t)(row0 + ai * HALF + m * 16) * ldc + col0;
#pragma unroll
                for (int bj = 0; bj < 2; ++bj)
#pragma unroll
                    for (int n = 0; n < 2; ++n) { const f32x4 b = *(const f32x4*)(base + off + bj * HALF + n * 16); *(f32x4*)(out + off + bj * HALF + n * 16) = b + acc[ai][bj][m][n] * alpha; } }
    }
};
struct EpiBf16S {
    static constexpr bool PERM = true;
    bf16_t* O; int ldc; const float* colscale;
    __device__ __forceinline__ void operator()(const f32x4 (&acc)[2][2][4][2], const Unit& u, int wr, int wc, int fr, int fq) const {
        const int row0 = u.pm * BM + wr * 64 + fr, col0 = u.pn * BM + wc * 32 + 8 * fq;
        f32x4 sv[2][2];
#pragma unroll
        for (int bj = 0; bj < 2; ++bj)
#pragma unroll
            for (int n = 0; n < 2; ++n) sv[bj][n] = colscale ? *(const f32x4*)(colscale + col0 + bj * HALF + 4 * n) : (f32x4){1.f, 1.f, 1.f, 1.f};
#pragma unroll
        for (int ai = 0; ai < 2; ++ai)
#pragma unroll
            for (int m = 0; m < 4; ++m) { bf16_t* rowp = O + (size_t)(row0 + ai * HALF + m * 16) * ldc + col0;
#pragma unroll
                for (int bj = 0; bj < 2; ++bj) { const f32x4 v0 = acc[ai][bj][m][0] * sv[bj][0], v1 = acc[ai][bj][m][1] * sv[bj][1];
                    u32x4 w; w.x = cvt_pk_bf16(v0[0], v0[1]); w.y = cvt_pk_bf16(v0[2], v0[3]); w.z = cvt_pk_bf16(v1[0], v1[1]); w.w = cvt_pk_bf16(v1[2], v1[3]);
                    *(u32x4*)(rowp + bj * HALF) = w; } }
    }
};
template <bool ADD> struct EpiMerge {
    static constexpr bool PERM = true;
    bf16_t* O; int ldc; const bf16_t* gate; int ldg;
    __device__ __forceinline__ void operator()(const f32x4 (&acc)[2][2][4][2], const Unit& u, int wr, int wc, int fr, int fq) const {
        const int row0 = u.pm * BM + wr * 64 + fr, col0 = u.pn * BM + wc * 32 + 8 * fq;
#pragma unroll
        for (int ai = 0; ai < 2; ++ai)
#pragma unroll
            for (int m = 0; m < 4; ++m) { const size_t r = (size_t)(row0 + ai * HALF + m * 16);
#pragma unroll
                for (int bj = 0; bj < 2; ++bj) {
                    const u32x4 gv = *(const u32x4*)(gate + r * ldg + col0 + bj * HALF);
                    u32x4 ov = (u32x4){0u, 0u, 0u, 0u}; if (ADD) ov = *(const u32x4*)(O + r * ldc + col0 + bj * HALF);
                    const f32x4 a0 = acc[ai][bj][m][0], a1 = acc[ai][bj][m][1];
                    float v[8];
                    v[0] = sigmoidf_(bf_lo(gv.x)) * a0[0]; v[1] = sigmoidf_(bf_hi(gv.x)) * a0[1]; v[2] = sigmoidf_(bf_lo(gv.y)) * a0[2]; v[3] = sigmoidf_(bf_hi(gv.y)) * a0[3];
                    v[4] = sigmoidf_(bf_lo(gv.z)) * a1[0]; v[5] = sigmoidf_(bf_hi(gv.z)) * a1[1]; v[6] = sigmoidf_(bf_lo(gv.w)) * a1[2]; v[7] = sigmoidf_(bf_hi(gv.w)) * a1[3];
                    if (ADD) { v[0] += bf_lo(ov.x); v[1] += bf_hi(ov.x); v[2] += bf_lo(ov.y); v[3] += bf_hi(ov.y); v[4] += bf_lo(ov.z); v[5] += bf_hi(ov.z); v[6] += bf_lo(ov.w); v[7] += bf_hi(ov.w); }
                    u32x4 w; w.x = cvt_pk_bf16(v[0], v[1]); w.y = cvt_pk_bf16(v[2], v[3]); w.z = cvt_pk_bf16(v[4], v[5]); w.w = cvt_pk_bf16(v[6], v[7]);
                    *(u32x4*)(O + r * ldc + col0 + bj * HALF) = w; } }
    }
};
struct EpiF32Split {
    static constexpr bool PERM = false;
    float* O; int ldc; int tmask, tshift; size_t sstride;
    __device__ __forceinline__ void operator()(const f32x4 (&acc)[2][2][4][2], const Unit& u, int wr, int wc, int fr, int fq) const {
        float* base = O + (size_t)(u.pn >> tshift) * sstride;
        const int row0 = u.pm * BM + wr * 64 + fr, col0 = (u.pn & tmask) * BM + wc * 32 + 4 * fq;
#pragma unroll
        for (int ai = 0; ai < 2; ++ai)
#pragma unroll
            for (int m = 0; m < 4; ++m) { float* rowp = base + (size_t)(row0 + ai * HALF + m * 16) * ldc + col0;
#pragma unroll
                for (int bj = 0; bj < 2; ++bj)
#pragma unroll
                    for (int n = 0; n < 2; ++n) *(f32x4*)(rowp + bj * HALF + n * 16) = acc[ai][bj][m][n]; }
    }
};

template <class Epi, class Sched, bool ALIGN_EPI = true>
__device__ __forceinline__ void gemm_phase(LAS unsigned char* lds, const Gemm g, const Sched& S, const Epi& E) {
    int tid = threadIdx.x; asm volatile("" : "+v"(tid));
    const int wid = __builtin_amdgcn_readfirstlane(tid >> 6), lane = tid & 63, wr = wid >> 2, wc = wid & 3, fr = lane & 15, fq = lane >> 4;
    const int K = g.K, nt = K / BK;
    unsigned voffA[2], voffB[2];
#pragma unroll
    for (int i = 0; i < 2; ++i) { int R, C; stage_rc(tid * 16 + i * 8192, R, C); const int Rb = Epi::PERM ? ((R & ~31) + perm32(R & 31)) : R;
        voffA[i] = (unsigned)(R * g.lda + C) * 2u; voffB[i] = (unsigned)(Rb * g.ldb + C) * 2u; }
    const size_t kstep = (size_t)(BK * 2);
    const size_t hstepA = (size_t)HALF * g.lda * 2, hstepB = (size_t)HALF * g.ldb * 2;
    const unsigned ldsw = (unsigned)wid * 1024u;
    const int aoff = lds_byte(wr * 64 + fr, fq * 8), boff = lds_byte(wc * 32 + fr, fq * 8);
#define PG8_SA(b, h) (((b) * 2 + (h)) * HTB)
#define PG8_SB(b, h) ((4 + (b) * 2 + (h)) * HTB)
#define PG8_STAGE(bufoff, gbase, voff) do { _Pragma("unroll") for (int _i = 0; _i < 2; ++_i) \
        __builtin_amdgcn_global_load_lds((const unsigned*)((const char*)(gbase) + (voff)[_i]), (LAS unsigned*)(lds + (bufoff) + ldsw + _i * 8192), 16, 0, 0); } while (0)
#define PG8_LDA(dst, b, h) do { _Pragma("unroll") for (int m = 0; m < 4; ++m) _Pragma("unroll") for (int k = 0; k < 2; ++k) dst[m][k] = *(const LAS bf16x8*)(lds + PG8_SA(b, h) + aoff + m * 2048 + k * 1024); } while (0)
#define PG8_LDB(dst, b, h) do { _Pragma("unroll") for (int n = 0; n < 2; ++n) _Pragma("unroll") for (int k = 0; k < 2; ++k) dst[n][k] = *(const LAS bf16x8*)(lds + PG8_SB(b, h) + boff + n * 2048 + k * 1024); } while (0)
#define PG8_MMA(ai, bj, At, Bt) do { __builtin_amdgcn_s_setprio(1); _Pragma("unroll") for (int m = 0; m < 4; ++m) _Pragma("unroll") for (int n = 0; n < 2; ++n) _Pragma("unroll") for (int k = 0; k < 2; ++k) \
        acc[ai][bj][m][n] = __builtin_amdgcn_mfma_f32_16x16x32_bf16(Bt[n][k], At[m][k], acc[ai][bj][m][n], 0, 0, 0); __builtin_amdgcn_s_setprio(0); } while (0)
#define PG8_WAIT_V(n) asm volatile("s_waitcnt vmcnt(" #n ")" ::: "memory")
#define PG8_WAIT_L(n) asm volatile("s_waitcnt lgkmcnt(" #n ")" ::: "memory")
#define PG8_BAR __builtin_amdgcn_s_barrier()
#define PG8_SCHED __builtin_amdgcn_sched_barrier(0)
#define PG8_APTR(u) ((const char*)g.A + ((size_t)(u).pm * BM * g.lda + (size_t)((u).pn >> g.ashift) * g.astride) * 2)
#define PG8_BPTR(u) ((const char*)g.Bt + ((size_t)((u).pn & g.bmask) * BM * g.ldb + (size_t)((u).pn >> g.ashift) * g.bstride) * 2)
    Unit cur, nxt; int ui = 0;
    if (!S.next(0, cur)) return;
    f32x4 acc[2][2][4][2];
#pragma unroll
    for (int a = 0; a < 2; ++a)
#pragma unroll
        for (int b = 0; b < 2; ++b)
#pragma unroll
            for (int m = 0; m < 4; ++m)
#pragma unroll
                for (int n = 0; n < 2; ++n) acc[a][b][m][n] = (f32x4){0.f, 0.f, 0.f, 0.f};
    bf16x8 At[4][2], B0[2][2], B1[2][2];
    const char* cA = PG8_APTR(cur); const char* cB = PG8_BPTR(cur);
    PG8_STAGE(PG8_SB(0, 0), cB, voffB); PG8_STAGE(PG8_SB(0, 1), cB + hstepB, voffB); PG8_STAGE(PG8_SA(0, 0), cA, voffA); PG8_STAGE(PG8_SA(0, 1), cA + hstepA, voffA);
    if (wr == 1) PG8_BAR;
    PG8_WAIT_V(2); PG8_BAR;
    PG8_STAGE(PG8_SB(1, 0), cB + kstep, voffB); PG8_STAGE(PG8_SA(1, 0), cA + kstep, voffA); PG8_STAGE(PG8_SB(1, 1), cB + hstepB + kstep, voffB);
    PG8_WAIT_V(6); PG8_BAR;
    for (;;) {
        const bool has_next = S.next(ui + 1, nxt);
        const char* nA = has_next ? PG8_APTR(nxt) : cA; const char* nB = has_next ? PG8_BPTR(nxt) : cB;
        for (int t = 0; t < nt; t += 2) {
            const bool last = (t == nt - 2);
            const char* a1 = cA + (size_t)(t + 1) * kstep;
            const char* a2 = last ? nA : cA + (size_t)(t + 2) * kstep; const char* b2 = last ? nB : cB + (size_t)(t + 2) * kstep;
            const char* a3 = a2 + kstep; const char* b3 = b2 + kstep;
            PG8_LDB(B0, 0, 0); PG8_LDB(B1, 0, 1); PG8_SCHED; PG8_LDA(At, 0, 0); PG8_STAGE(PG8_SA(1, 1), a1 + hstepA, voffA);
            PG8_WAIT_V(8); PG8_WAIT_L(0); PG8_BAR; PG8_MMA(0, 0, At, B0); PG8_MMA(0, 1, At, B1); PG8_BAR; PG8_SCHED;
            PG8_LDA(At, 0, 1); PG8_STAGE(PG8_SB(0, 0), b2, voffB); PG8_STAGE(PG8_SB(0, 1), b2 + hstepB, voffB); PG8_STAGE(PG8_SA(0, 0), a2, voffA);
            PG8_WAIT_V(8); PG8_WAIT_L(0); PG8_BAR; PG8_MMA(1, 0, At, B0); PG8_MMA(1, 1, At, B1); PG8_BAR; PG8_SCHED;
            PG8_LDB(B0, 1, 0); PG8_LDB(B1, 1, 1); PG8_SCHED; PG8_LDA(At, 1, 0); PG8_STAGE(PG8_SA(0, 1), a2 + hstepA, voffA);
            PG8_WAIT_V(8); PG8_WAIT_L(0); PG8_BAR; PG8_MMA(0, 0, At, B0); PG8_MMA(0, 1, At, B1); PG8_BAR; PG8_SCHED;
            PG8_LDA(At, 1, 1); PG8_STAGE(PG8_SB(1, 0), b3, voffB); PG8_STAGE(PG8_SB(1, 1), b3 + hstepB, voffB); PG8_STAGE(PG8_SA(1, 0), a3, voffA);
            PG8_WAIT_V(8); PG8_WAIT_L(0); PG8_BAR; PG8_MMA(1, 0, At, B0); PG8_MMA(1, 1, At, B1); PG8_BAR; PG8_SCHED;
        }
        if constexpr (ALIGN_EPI) { if (wr == 0) PG8_BAR; }
        E(acc, cur, wr, wc, fr, fq);
        if (!has_next) break;
#pragma unroll
        for (int a = 0; a < 2; ++a)
#pragma unroll
            for (int b = 0; b < 2; ++b)
#pragma unroll
                for (int m = 0; m < 4; ++m)
#pragma unroll
                    for (int n = 0; n < 2; ++n) acc[a][b][m][n] = (f32x4){0.f, 0.f, 0.f, 0.f};
        cur = nxt; cA = nA; cB = nB; ++ui;
        if constexpr (ALIGN_EPI) { if (wr == 1) PG8_BAR; }
    }
    PG8_WAIT_V(0);
    if constexpr (!ALIGN_EPI) { if (wr == 0) PG8_BAR; }
    PG8_BAR;
#undef PG8_SA
#undef PG8_SB
#undef PG8_STAGE
#undef PG8_LDA
#undef PG8_LDB
#undef PG8_MMA
#undef PG8_WAIT_V
#undef PG8_WAIT_L
#undef PG8_BAR
#undef PG8_SCHED
#undef PG8_APTR
#undef PG8_BPTR
}
}

namespace att {
constexpr int KVBLK = 64, QBLK = 32, NW = 8;
constexpr int SHM_V = KVBLK * 128 * 2;
constexpr float THR2 = 11.5f;
#define ATT_KSWZ(row, colB, KROW) ((row) * (KROW) + (colB))
#define ATT_SBAR() __builtin_amdgcn_sched_barrier(0)
__device__ __forceinline__ int crow(int r, int hi) { return (r & 3) + 8 * (r >> 2) + 4 * hi; }

__device__ __forceinline__ void partialSM(f32x16& p0, f32x16& p1, float& m_reg, float& mn, float& alpha) {
    float pmax = p0[0];
#pragma unroll
    for (int r = 1; r < 16; ++r) pmax = fmaxf(pmax, p0[r]);
#pragma unroll
    for (int r = 0; r < 16; ++r) pmax = fmaxf(pmax, p1[r]);
    { auto rr = __builtin_amdgcn_permlane32_swap(__float_as_uint(pmax), __float_as_uint(pmax), false, false);
      pmax = fmaxf(__uint_as_float(rr[0]), __uint_as_float(rr[1])); }
    if (__builtin_expect(__all(pmax - m_reg <= THR2), 1)) { mn = m_reg; alpha = 1.f; }
    else { mn = fmaxf(m_reg, pmax); alpha = __builtin_amdgcn_exp2f(m_reg - mn); m_reg = mn; }
#pragma unroll
    for (int r = 0; r < 16; ++r) p0[r] = p0[r] - mn;
#pragma unroll
    for (int r = 0; r < 16; ++r) p1[r] = p1[r] - mn;
#pragma unroll
    for (int r = 0; r < 16; ++r) p0[r] = __builtin_amdgcn_exp2f(p0[r]);
}
__device__ __forceinline__ void finishSM(f32x16& p0, f32x16& p1, float alpha, float& l_reg, bf16x8& pa0, bf16x8& pa1, bf16x8& pa2, bf16x8& pa3) {
#pragma unroll
    for (int r = 0; r < 16; ++r) p1[r] = __builtin_amdgcn_exp2f(p1[r]);
    float ps = 0;
#pragma unroll
    for (int r = 0; r < 16; ++r) ps += p0[r];
#pragma unroll
    for (int r = 0; r < 16; ++r) ps += p1[r];
    { auto rr = __builtin_amdgcn_permlane32_swap(__float_as_uint(ps), __float_as_uint(ps), false, false);
      ps = __uint_as_float(rr[0]) + __uint_as_float(rr[1]); }
    l_reg = l_reg * alpha + ps;
#define ATT_PK4(P, BASE, OUT) do { unsigned a0 = cvt_pk_bf16(P[BASE + 0], P[BASE + 1]), a1 = cvt_pk_bf16(P[BASE + 2], P[BASE + 3]);   \
    unsigned b0 = cvt_pk_bf16(P[BASE + 4], P[BASE + 5]), b1 = cvt_pk_bf16(P[BASE + 6], P[BASE + 7]);                              \
    auto r0 = __builtin_amdgcn_permlane32_swap(a0, b0, false, false); auto r1 = __builtin_amdgcn_permlane32_swap(a1, b1, false, false); \
    u32x4 w = {r0[0], r1[0], r0[1], r1[1]}; OUT = __builtin_bit_cast(bf16x8, w); } while (0)
    ATT_PK4(p0, 0, pa0); ATT_PK4(p0, 8, pa1); ATT_PK4(p1, 0, pa2); ATT_PK4(p1, 8, pa3);
#undef ATT_PK4
}
template <int DK> __device__ __forceinline__ void qkt(f32x16& p0, f32x16& p1, const char* Ks, const bf16x8* qr, int r32, int hi) {
    p0 = f32x16{}; p1 = f32x16{};
#pragma unroll
    for (int d0 = 0; d0 < DK / 16; ++d0) { const int cb = (d0 * 16 + hi * 8) * 2;
        const bf16x8 b0 = *reinterpret_cast<const bf16x8*>(Ks + ATT_KSWZ(r32, cb, DK * 2 + 16));
        const bf16x8 b1 = *reinterpret_cast<const bf16x8*>(Ks + ATT_KSWZ(32 + r32, cb, DK * 2 + 16));
        p0 = __builtin_amdgcn_mfma_f32_32x32x16_bf16(b0, qr[d0], p0, 0, 0, 0);
        p1 = __builtin_amdgcn_mfma_f32_32x32x16_bf16(b1, qr[d0], p1, 0, 0, 0); }
}
__device__ __forceinline__ void cmask(f32x16& p0, f32x16& p1, int t, int qrel, int hi) {
    const float ninf = -__builtin_inff();
#pragma unroll
    for (int r = 0; r < 16; ++r) { const int k0 = 64 * t + crow(r, hi); if (k0 > qrel) p0[r] = ninf; if (k0 + 32 > qrel) p1[r] = ninf; }
}
__device__ __forceinline__ int v_st(int k, int c) { const int kk = (k & ~0xC) | ((k & 4) << 1) | ((k & 8) >> 1); return ((kk >> 3) * 4 + (c >> 5)) * 512 + ((kk & 7) * 32 + (c & 31)) * 2; }
__device__ __forceinline__ int v_rd_base(int lane) { return ((lane & 3) << 3) | (((lane >> 2) & 3) << 6) | (((lane >> 4) & 1) << 5) | (((lane >> 5) & 1) << 8); }
constexpr int v_rd_off(int d0, int ks, int half) { return d0 * 512 + ks * 4096 + half * 2048; }
template <int OFF> __device__ __forceinline__ s16x4 tr_read(int vb) {
    s16x4 r; asm volatile("ds_read_b64_tr_b16 %0, %1 offset:%2" : "=&v"(r) : "v"(vb), "i"(OFF) : "memory"); return r;
}
template <int D0> __device__ __forceinline__ void pv_one(f32x16& od, int vb, bf16x8 pa0, bf16x8 pa1, bf16x8 pa2, bf16x8 pa3) {
    const s16x4 l0 = tr_read<v_rd_off(D0, 0, 0)>(vb), h0 = tr_read<v_rd_off(D0, 0, 1)>(vb), l1 = tr_read<v_rd_off(D0, 1, 0)>(vb), h1 = tr_read<v_rd_off(D0, 1, 1)>(vb);
    const s16x4 l2 = tr_read<v_rd_off(D0, 2, 0)>(vb), h2 = tr_read<v_rd_off(D0, 2, 1)>(vb), l3 = tr_read<v_rd_off(D0, 3, 0)>(vb), h3 = tr_read<v_rd_off(D0, 3, 1)>(vb);
    asm volatile("s_waitcnt lgkmcnt(0)" ::: "memory"); ATT_SBAR();
#define ATT_PK(L, H) (bf16x8){L[0], L[1], L[2], L[3], H[0], H[1], H[2], H[3]}
    od = __builtin_amdgcn_mfma_f32_32x32x16_bf16(pa0, ATT_PK(l0, h0), od, 0, 0, 0);
    od = __builtin_amdgcn_mfma_f32_32x32x16_bf16(pa1, ATT_PK(l1, h1), od, 0, 0, 0);
    od = __builtin_amdgcn_mfma_f32_32x32x16_bf16(pa2, ATT_PK(l2, h2), od, 0, 0, 0);
    od = __builtin_amdgcn_mfma_f32_32x32x16_bf16(pa3, ATT_PK(l3, h3), od, 0, 0, 0);
#undef ATT_PK
}
__device__ __forceinline__ void pv_d0(f32x16* o, int vb, bf16x8 pa0, bf16x8 pa1, bf16x8 pa2, bf16x8 pa3) {
    pv_one<0>(o[0], vb, pa0, pa1, pa2, pa3); pv_one<1>(o[1], vb, pa0, pa1, pa2, pa3); pv_one<2>(o[2], vb, pa0, pa1, pa2, pa3); pv_one<3>(o[3], vb, pa0, pa1, pa2, pa3);
}

template <int DK, bool CAUSAL>
__device__ __forceinline__ void attn_unit(const bf16x8 (&qr)[DK / 16], const bf16_t* __restrict__ Kn, int ldk, const bf16_t* __restrict__ Kr, int ldkr,
                                          const bf16_t* __restrict__ V, int ldv, bf16_t* __restrict__ O, int ldo, int NT, char* lds) {
    constexpr int KROW = DK * 2 + 16, SHM_K = KVBLK * KROW;
    int tid = threadIdx.x; asm volatile("" : "+v"(tid));
    const int wid = tid >> 6, lane = tid & 63, r32 = lane & 31, hi = lane >> 5;
    char* V_lds = lds; char* K_lds = lds + 2 * SHM_V;
    float* wsf = (float*)(lds + 2 * SHM_V + 2 * SHM_K) + wid * 64; float* li_l = wsf; float* al_l = wsf + 32;
    float m_reg = -1e30f, l_reg = 0; f32x16 o[4] = {};
    const int sr = tid >> 4, sc = (tid & 15) * 8, vst0 = v_st(sr, sc), vst1 = v_st(32 + sr, sc);
    const int rr = tid >> 3, rc = (tid & 7) * 8;
    const int vb0 = (int)(uintptr_t)V_lds + v_rd_base(lane);
    bf16x8 vs0, vs1, ks0, ks1, kr0;
#define SLOAD(k0) do { vs0 = *(const bf16x8*)(V + (size_t)((k0) + sr) * ldv + sc); vs1 = *(const bf16x8*)(V + (size_t)((k0) + 32 + sr) * ldv + sc); \
    ks0 = *(const bf16x8*)(Kn + (size_t)((k0) + sr) * ldk + sc); ks1 = *(const bf16x8*)(Kn + (size_t)((k0) + 32 + sr) * ldk + sc); \
    if constexpr (DK == 192) kr0 = *(const bf16x8*)(Kr + (size_t)((k0) + rr) * ldkr + rc); } while (0)
#define SWRITE(b) do { *(bf16x8*)(V_lds + (b) * SHM_V + vst0) = vs0; *(bf16x8*)(V_lds + (b) * SHM_V + vst1) = vs1; const int kc = sc * 2; \
    *(bf16x8*)(K_lds + (b) * SHM_K + ATT_KSWZ(sr, kc, KROW)) = ks0; *(bf16x8*)(K_lds + (b) * SHM_K + ATT_KSWZ(32 + sr, kc, KROW)) = ks1; \
    if constexpr (DK == 192) *(bf16x8*)(K_lds + (b) * SHM_K + ATT_KSWZ(rr, 256 + rc * 2, KROW)) = kr0; } while (0)
#define SWAIT() asm volatile("s_waitcnt vmcnt(0)" ::: "memory")
#define RESC(a) do { if (__any((a) < 1.f)) { if (hi == 0) al_l[r32] = (a); asm volatile("s_waitcnt lgkmcnt(0)" ::: "memory"); \
    _Pragma("unroll") for (int d = 0; d < 4; ++d) _Pragma("unroll") for (int r = 0; r < 16; ++r) o[d][r] *= al_l[crow(r, hi)]; } } while (0)
#define MASK(P0, P1, j) do { if (CAUSAL) { const int t_ = (j) - (NT - 4); if (t_ >= 0 && 64 * t_ + 63 > 32 * wid) cmask(P0, P1, t_, 32 * wid + r32, hi); } } while (0)
    f32x16 p0, p1; float mn, al; bf16x8 pa0, pa1, pa2, pa3;
    SLOAD(0); SWAIT(); SWRITE(0); __syncthreads();
#define ATT_STEP(j, b) do { \
        if ((j) + 1 < NT) SLOAD(((j) + 1) * KVBLK); ATT_SBAR(); \
        qkt<DK>(p0, p1, K_lds + (b) * SHM_K, qr, r32, hi); MASK(p0, p1, (j)); partialSM(p0, p1, m_reg, mn, al); RESC(al); \
        finishSM(p0, p1, al, l_reg, pa0, pa1, pa2, pa3); ATT_SBAR(); \
        pv_d0(o, vb0 + (b) * SHM_V, pa0, pa1, pa2, pa3); \
        if ((j) + 1 < NT) { SWAIT(); SWRITE((b) ^ 1); } \
        __syncthreads(); } while (0)
    for (int j = 0; j < NT; j += 2) { ATT_STEP(j, 0); ATT_STEP(j + 1, 1); }
#undef ATT_STEP
    if (hi == 0) li_l[r32] = l_reg; asm volatile("s_waitcnt lgkmcnt(0)" ::: "memory");
    float rli[16];
#pragma unroll
    for (int r = 0; r < 16; ++r) rli[r] = __builtin_amdgcn_rcpf(li_l[crow(r, hi)]);
    bf16_t* Ow = O + (size_t)(wid * QBLK) * ldo;
#pragma unroll
    for (int r = 0; r < 16; ++r) { const int orow = crow(r, hi);
#pragma unroll
        for (int d0 = 0; d0 < 4; ++d0) { const unsigned w = cvt_pk_bf16(o[d0][r] * rli[r], 0.f); Ow[(size_t)orow * ldo + d0 * 32 + r32] = (bf16_t)(w & 0xffffu); } }
    __syncthreads();
#undef SLOAD
#undef SWRITE
#undef SWAIT
#undef RESC
#undef MASK
}
}

#define XB_TMO      128
#define XB_XCNT(j)  (256  + 64 * (j))
#define XB_XSUB(j)  (1280 + 64 * (j))
#define XB_XGEN(j)  (2304 + 64 * (j))
#define XB_TOP      3328
#define XB_TOPGEN   3392
#define XCD_BAR_WORDS 3456
#define XB_SPIN_CAP (1u << 18)
__device__ __forceinline__ unsigned xb_ld(unsigned* p)              { return __hip_atomic_load(p, __ATOMIC_RELAXED, __HIP_MEMORY_SCOPE_AGENT); }
__device__ __forceinline__ unsigned xb_add(unsigned* p, unsigned v) { return __hip_atomic_fetch_add(p, v, __ATOMIC_RELAXED, __HIP_MEMORY_SCOPE_AGENT); }
__device__ __forceinline__ unsigned xb_xcc_id() { return (unsigned)__builtin_amdgcn_s_getreg((3 << 11) | 20) & 0xFu; }
#define XB_SPIN(cond, bar) do { unsigned _sp = 0; while (cond) { __builtin_amdgcn_s_sleep(1); \
    if ((++_sp & 255u) == 0u) { if (xb_ld(&(bar)[XB_TMO])) break; if (_sp > XB_SPIN_CAP) { atomicAdd(&(bar)[XB_TMO], 1u); break; } } } } while (0)
struct XcdBarrier { unsigned* bar; unsigned x; volatile LAS unsigned* st; };
__device__ __forceinline__ XcdBarrier xcd_barrier_post(unsigned* bar, volatile LAS unsigned* st) {
    XcdBarrier b; b.bar = bar; b.x = xb_xcc_id(); b.st = st;
    if (threadIdx.x == 0) (void)xb_add(&bar[XB_XCNT(b.x)], 1u);
    return b;
}
__device__ __forceinline__ void xcd_barrier_complete(unsigned* bar, unsigned x, unsigned& nloc, unsigned& nx) {
    const unsigned G = gridDim.x * gridDim.y * gridDim.z;
    unsigned sum, cnt, mine, sp = 0u;
    for (;;) {
        sum = 0u; cnt = 0u; mine = 0u;
#pragma unroll
        for (unsigned j = 0; j < 16; ++j) { const unsigned c = xb_ld(&bar[XB_XCNT(j)]); sum += c; cnt += (c > 0u) ? 1u : 0u; mine = (j == x) ? c : mine; }
        if (sum == G) break;
        __builtin_amdgcn_s_sleep(1);
        if ((++sp & 255u) == 0u) { if (xb_ld(&bar[XB_TMO])) break; if (sp > XB_SPIN_CAP) { atomicAdd(&bar[XB_TMO], 1u); break; } }
    }
    nloc = mine > 0u ? mine : 1u; nx = cnt > 0u ? cnt : 1u;
}
__device__ __forceinline__ void xcd_barrier(const XcdBarrier& b) {
    asm volatile("s_waitcnt vmcnt(0)" ::: "memory");
    __syncthreads();
    if (threadIdx.x == 0) {
        unsigned* bar = b.bar;
        __builtin_amdgcn_s_waitcnt(0);
        unsigned nloc = b.st[0], nx = b.st[1];
        if (nloc == 0u) { xcd_barrier_complete(bar, b.x, nloc, nx); b.st[0] = nloc; b.st[1] = nx; }
        const unsigned old = xb_add(&bar[XB_XSUB(b.x)], 1u);
        const unsigned gen = old / nloc;
        if (old + 1u == (gen + 1u) * nloc) {
            __builtin_amdgcn_fence(__ATOMIC_RELEASE, "agent");
            asm volatile("s_waitcnt vmcnt(0)" ::: "memory");
            const unsigned og = xb_add(&bar[XB_TOP], 1u);
            const unsigned tg = og / nx;
            if (og + 1u == (tg + 1u) * nx) xb_add(&bar[XB_TOPGEN], 1u);
            else XB_SPIN(xb_ld(&bar[XB_TOPGEN]) == tg, bar);
            __builtin_amdgcn_fence(__ATOMIC_ACQUIRE, "agent");
            xb_add(&bar[XB_XGEN(b.x)], 1u);
            asm volatile("s_waitcnt vmcnt(0)" ::: "memory");
        } else {
            XB_SPIN(xb_ld(&bar[XB_XGEN(b.x)]) == gen, bar);
            __builtin_amdgcn_fence(__ATOMIC_ACQUIRE, "agent");
            asm volatile("s_waitcnt vmcnt(0)" ::: "memory");
        }
    }
    __syncthreads();
}

constexpr int NWAVES = 8;
enum { I_X = 0, I_MEM, I_POS, I_F1N, I_F1GU, I_F1DN, I_MIXN, I_WIN, I_WPOOL, I_PSCALE, I_QLN, I_KVLN, I_WUQ, I_WUKV, I_QNN, I_KNN, I_QRN, I_KRN,
       I_WBP, I_WBM, I_WOUT, I_XNORM, I_MEMN, I_WXQ, I_WXKV, I_XQN, I_XKN, I_WXO, I_F2N, I_F2GU, I_F2DN, N_IN };
struct Params { const float* in[N_IN]; float* out; unsigned char* ws; int ph_lo, ph_hi; };
static_assert(sizeof(Params) == (N_IN + 2) * 8 + 8, "Params has no padding");


__constant__ float c_inv_freq[32] = {
    1.000000000e+00f, 7.498942018e-01f, 5.623413324e-01f, 4.216965139e-01f, 3.162277639e-01f, 2.371373922e-01f, 1.778279394e-01f, 1.333521456e-01f,
    1.000000015e-01f, 7.498941571e-02f, 5.623412877e-02f, 4.216964915e-02f, 3.162277862e-02f, 2.371373586e-02f, 1.778279431e-02f, 1.333521493e-02f,
    9.999999776e-03f, 7.498942316e-03f, 5.623413250e-03f, 4.216964822e-03f, 3.162277862e-03f, 2.371373819e-03f, 1.778279431e-03f, 1.333521446e-03f,
    1.000000047e-03f, 7.498941850e-04f, 5.623413017e-04f, 4.216965463e-04f, 3.162277862e-04f, 2.371373848e-04f, 1.778279402e-04f, 1.333521504e-04f};

#define LDS_WAIT() asm volatile("s_waitcnt lgkmcnt(0)" ::: "memory")
__device__ __forceinline__ float wave_sum(float v) {
#pragma unroll
    for (int o = 1; o < 64; o <<= 1) v += __shfl_xor(v, o);
    return v;
}
__device__ __forceinline__ unsigned f2bf(float f) { unsigned u = __builtin_bit_cast(unsigned, f); return (u + 0x7fffu + ((u >> 16) & 1u)) >> 16; }
__device__ __forceinline__ unsigned pk2(float lo, float hi) { return f2bf(lo) | (f2bf(hi) << 16); }

template <int MAP> __device__ __forceinline__ int dst_row_of(int n0) {
    if (MAP == 1) { const int isu = n0 >= FF, j = isu ? n0 - FF : n0; return (j >> 7) * 256 + isu * 128 + (j & 127); }
    if (MAP == 2) { if (n0 < 3584) return n0; if (n0 < 3648) return Z_KR + (n0 - 3584); if (n0 < 7744) return Z_GP + (n0 - 3648); return Z_GM + (n0 - 7744); }
    return n0;
}
template <int MAP> __device__ __forceinline__ void transpose_item(const float* W, int K, int N, bf16_t* WT, LAS float* scr, int item, int lane) {
    const int nblk = N / 32, kb = item / nblk, nb = item % nblk, k0 = 64 * kb, n0 = 32 * nb, d0 = dst_row_of<MAP>(n0);
#pragma unroll 8
    for (int i = 0; i < 32; ++i) { const int kk = 2 * i + (lane >> 5); scr[kk * 33 + (lane & 31)] = W[(size_t)(k0 + kk) * N + n0 + (lane & 31)]; }
    LDS_WAIT(); asm volatile("" ::: "memory");
    const int c = lane & 7;
#pragma unroll
    for (int j = 0; j < 4; ++j) { const int n = (lane >> 3) + 8 * j; const LAS float* s = scr + (8 * c) * 33 + n;
        u32x4 o; o.x = pk2(s[0 * 33], s[1 * 33]); o.y = pk2(s[2 * 33], s[3 * 33]); o.z = pk2(s[4 * 33], s[5 * 33]); o.w = pk2(s[6 * 33], s[7 * 33]);
        *(GAS u32x4*)(WT + (size_t)(d0 + n) * K + k0 + 8 * c) = o; }
    LDS_WAIT(); asm volatile("" ::: "memory");
}
__device__ __forceinline__ void rms_row_4096(const float* xrow, const float* gain, bf16_t* orow, int lane) {
    const f32x4* xr = (const f32x4*)xrow + lane * 2; const f32x4* gr = (const f32x4*)gain + lane * 2;
    f32x4 v[16]; float s = 0.f;
#pragma unroll
    for (int j = 0; j < 8; ++j) { v[2 * j] = xr[128 * j]; v[2 * j + 1] = xr[128 * j + 1];
        s += (v[2 * j].x * v[2 * j].x + v[2 * j].y * v[2 * j].y) + (v[2 * j].z * v[2 * j].z + v[2 * j].w * v[2 * j].w);
        s += (v[2 * j + 1].x * v[2 * j + 1].x + v[2 * j + 1].y * v[2 * j + 1].y) + (v[2 * j + 1].z * v[2 * j + 1].z + v[2 * j + 1].w * v[2 * j + 1].w); }
    const float rstd = rsqrtf(wave_sum(s) * (1.f / 4096.f) + EPS);
    u32x4* o16 = (u32x4*)orow + lane;
#pragma unroll
    for (int j = 0; j < 8; ++j) { const f32x4 g0 = gr[128 * j], g1 = gr[128 * j + 1]; const f32x4 a = v[2 * j] * rstd * g0, b = v[2 * j + 1] * rstd * g1;
        u32x4 w; w.x = cvt_pk_bf16(a.x, a.y); w.y = cvt_pk_bf16(a.z, a.w); w.z = cvt_pk_bf16(b.x, b.y); w.w = cvt_pk_bf16(b.z, b.w); o16[64 * j] = w; }
}
__device__ __forceinline__ void unpack8(const u32x4 v, float (&f)[8]) { f[0] = bf_lo(v.x); f[1] = bf_hi(v.x); f[2] = bf_lo(v.y); f[3] = bf_hi(v.y); f[4] = bf_lo(v.z); f[5] = bf_hi(v.z); f[6] = bf_lo(v.w); f[7] = bf_hi(v.w); }
__device__ __forceinline__ u32x4 pack8(const float (&f)[8]) { u32x4 w; w.x = cvt_pk_bf16(f[0], f[1]); w.y = cvt_pk_bf16(f[2], f[3]); w.z = cvt_pk_bf16(f[4], f[5]); w.w = cvt_pk_bf16(f[6], f[7]); return w; }

constexpr int N_PHASES = 19;

__global__ void __launch_bounds__(NWAVES * 64, 2) mk_fwd(Params P) {
    extern __shared__ __attribute__((aligned(16))) unsigned char lds_raw[];
#define LDSP ((LAS unsigned char*)lds_raw)
#define WSB (P.ws)
    unsigned* ctl = (unsigned*)(WSB + WS_CTL);
    for (int u = threadIdx.x; u < (LDS_BYTES - LDSCTL_OFF) / 4; u += NWAVES * 64) ((LAS unsigned*)(LDSP + LDSCTL_OFF))[u] = 0u;
    __syncthreads();
#if MK_ONE_LAUNCH
    (void)xcd_barrier_post(ctl + CW_BAR, (volatile LAS unsigned*)(LDSP + MISC_OFF) + 8);
#define GRID_BAR() do { XcdBarrier b_; b_.bar = (unsigned*)(WSB + WS_CTL) + CW_BAR; b_.x = xb_xcc_id(); b_.st = (volatile LAS unsigned*)((LAS unsigned char*)lds_raw + MISC_OFF) + 8; xcd_barrier(b_); } while (0)
    constexpr int lo = 0, hi = N_PHASES;
#else
#define GRID_BAR() do { } while (0)
    const int lo = P.ph_lo, hi = P.ph_hi;
#endif
#ifndef MK_PHASES
#define MK_PHASES 0x7ffff
#endif
#define IN(k) ((((MK_PHASES) >> (k)) & 1) && lo <= (k) && (k) < hi)
#define SEAM(k) do { if (IN(k) && IN((k) + 1)) GRID_BAR(); } while (0)
#define PHASE_IDS() int tid_ = threadIdx.x; asm volatile("" : "+v"(tid_)); const int lane = tid_ & 63, wave_ = __builtin_amdgcn_readfirstlane(tid_ >> 6); \
    const int G_ = gridDim.x, vcu_ = (G_ % 8 == 0) ? ((int)blockIdx.x % 8) * (G_ / 8) + (int)blockIdx.x / 8 : (int)blockIdx.x, gw = vcu_ * NWAVES + wave_, NGW = G_ * NWAVES; (void)gw; (void)NGW; (void)lane; (void)vcu_; (void)wave_

#define WGU ((bf16_t*)(WSB + WS_WGU))
#define WDN ((bf16_t*)(WSB + WS_WDN))
#define WIN ((bf16_t*)(WSB + WS_WIN))
#define WPOOL ((bf16_t*)(WSB + WS_WPOOL))
#define WUQ ((bf16_t*)(WSB + WS_WUQ))
#define WUKV ((bf16_t*)(WSB + WS_WUKV))
#define WBP ((bf16_t*)(WSB + WS_WBP))
#define WBM ((bf16_t*)(WSB + WS_WBM))
#define WOUT ((bf16_t*)(WSB + WS_WOUT))
#define WXQ ((bf16_t*)(WSB + WS_WXQ))
#define WXKV ((bf16_t*)(WSB + WS_WXKV))
#define WXO ((bf16_t*)(WSB + WS_WXO))
#define XN ((bf16_t*)(WSB + WS_XN))
#define MN ((bf16_t*)(WSB + WS_MN))
#define XKV ((float*)(WSB + WS_XKV))
#define XKB ((bf16_t*)(WSB + WS_XKB))
#define XVB ((bf16_t*)(WSB + WS_XVB))
#define HID ((bf16_t*)(WSB + WS_HID))
#define Z ((bf16_t*)(WSB + WS_Z))
#define CQ ((bf16_t*)(WSB + WS_CQ))
#define CKV ((bf16_t*)(WSB + WS_CKV))
#define KR ((bf16_t*)(WSB + WS_KR))
#define PM ((bf16_t*)(WSB + WS_PM))
#define QB ((bf16_t*)(WSB + WS_Q))
#define KVB ((bf16_t*)(WSB + WS_KV))
#define AO ((bf16_t*)(WSB + WS_AO))
#define BO ((bf16_t*)(WSB + WS_BO))
#define MG XN
#define XQP ((float*)(WSB + WS_XQP))
#define XO ((bf16_t*)(WSB + WS_XO))
#define OUT (P.out)

#define TRANSPOSE_JOB(MAP, SRC, KK, NN, DST) { const int nit = ((KK) / 64) * ((NN) / 32); if (r < nit) { transpose_item<MAP>((SRC), (KK), (NN), (DST), scr, r, lane); continue; } r -= nit; }

    if (IN(0)) {
        PHASE_IDS();
        LAS float* scr = (LAS float*)(LDSP + wave_ * 16384);
        constexpr int TOT = (D / 64) * (2 * FF / 32) + (FF / 64) * (D / 32) + (D / 64) * (11840 / 32) + (2048 / 64) * (512 / 32) + (1024 / 64) * (3072 / 32) + (512 / 64) * (4096 / 32)
                          + 2 * (2048 / 64) * (4096 / 32) + (4096 / 64) * (4096 / 32) + (4096 / 64) * (512 / 32) + (4096 / 64) * (1024 / 32) + (512 / 64) * (4096 / 32);
        for (int it = gw; it < TOT; it += NGW) {
            int r = it;
            TRANSPOSE_JOB(1, P.in[I_F1GU], D, 2 * FF, WGU)
            TRANSPOSE_JOB(0, P.in[I_F1DN], FF, D, WDN)
            TRANSPOSE_JOB(2, P.in[I_WIN], D, 11840, WIN)
            TRANSPOSE_JOB(0, P.in[I_WPOOL], 2048, 512, WPOOL)
            TRANSPOSE_JOB(0, P.in[I_WUQ], 1024, 3072, WUQ)
            TRANSPOSE_JOB(0, P.in[I_WUKV], 512, 4096, WUKV)
            TRANSPOSE_JOB(0, P.in[I_WBP], 2048, 4096, WBP)
            TRANSPOSE_JOB(0, P.in[I_WBM], 2048, 4096, WBM)
            TRANSPOSE_JOB(0, P.in[I_WOUT], 4096, 4096, WOUT)
            TRANSPOSE_JOB(0, P.in[I_WXQ], 4096, 512, WXQ)
            TRANSPOSE_JOB(0, P.in[I_WXKV], 4096, 1024, WXKV)
            TRANSPOSE_JOB(0, P.in[I_WXO], 512, 4096, WXO)
        }
        { u32x4* zp = (u32x4*)(WIN + (size_t)11840 * D); const int n16 = 192 * D * 2 / 16; for (int i = gw * 64 + lane; i < n16; i += NGW * 64) zp[i] = (u32x4){0u, 0u, 0u, 0u}; }
        for (int m = gw; m < M; m += NGW) rms_row_4096(P.in[I_X] + (size_t)m * D, P.in[I_F1N], XN + (size_t)m * D, lane);
        for (int m = gw; m < MMEM; m += NGW) rms_row_4096(P.in[I_MEM] + (size_t)m * D, P.in[I_MEMN], MN + (size_t)m * D, lane);
    }
    SEAM(0);
    if (IN(1)) {
        pg8::Gemm g = pg8::mk_gemm(XN, WGU, D, D, D); pg8::StaticOrder S; S.init(M / 256, FF / 128, (int)gridDim.x, (int)blockIdx.x);
        pg8::EpiSwiGLU E{HID, FF};
        pg8::gemm_phase(LDSP, g, S, E);
    }
    SEAM(1);
    if (IN(2)) {
        pg8::Gemm g = pg8::mk_gemm(HID, WDN, FF, FF, FF); pg8::StaticOrder S; S.init(M / 256, D / 256, (int)gridDim.x, (int)blockIdx.x);
        pg8::EpiResF32 E{P.in[I_X], OUT, D, 0.5f};
        pg8::gemm_phase(LDSP, g, S, E);
    }
    SEAM(2);
    if (IN(3)) {
        PHASE_IDS();
        for (int m = gw; m < M; m += NGW) rms_row_4096(OUT + (size_t)m * D, P.in[I_MIXN], XN + (size_t)m * D, lane);
        LAS float* scr = (LAS float*)(LDSP + wave_ * 16384);
        constexpr int TOT = (D / 64) * (2 * FF / 32) + (FF / 64) * (D / 32);
        for (int it = gw; it < TOT; it += NGW) {
            int r = it;
            TRANSPOSE_JOB(1, P.in[I_F2GU], D, 2 * FF, WGU)
            TRANSPOSE_JOB(0, P.in[I_F2DN], FF, D, WDN)
        }
    }
    SEAM(3);
    if (IN(4)) {
        { pg8::Gemm g = pg8::mk_gemm(XN, WIN, D, D, D); pg8::StaticOrder S; S.init(M / 256, ZW / 256, (int)gridDim.x, (int)blockIdx.x);
          pg8::EpiBf16S E{Z, ZW, nullptr};
          pg8::gemm_phase(LDSP, g, S, E); }
        { pg8::Gemm g = pg8::mk_gemm(MN, WXKV, D, D, D); pg8::StaticOrder S; S.init(MMEM / 256, 1024 / 256, (int)gridDim.x, (int)((blockIdx.x + 64u) % (unsigned)(int)gridDim.x));
          pg8::EpiF32Split E{XKV, 1024, 0x7fffffff, 30, 0};
          pg8::gemm_phase(LDSP, g, S, E); }
    }
    SEAM(4);
    if (IN(5)) {
        PHASE_IDS();
        const float* gq = P.in[I_QLN]; const float* gkv = P.in[I_KVLN]; const float* gkr = P.in[I_KRN]; const int* pos = (const int*)P.in[I_POS];
        for (int m = gw; m < M; m += NGW) {
            const bf16_t* zr = Z + (size_t)m * ZW;
            {
                float a[8], b[8]; unpack8(*(const u32x4*)(zr + Z_ZQ + lane * 8), a); unpack8(*(const u32x4*)(zr + Z_ZQ + 512 + lane * 8), b);
                float s = 0.f;
#pragma unroll
                for (int e = 0; e < 8; ++e) s += a[e] * a[e] + b[e] * b[e];
                const float rstd = rsqrtf(wave_sum(s) * (1.f / 1024.f) + EPS);
#pragma unroll
                for (int e = 0; e < 8; ++e) { a[e] *= rstd * gq[lane * 8 + e]; b[e] *= rstd * gq[512 + lane * 8 + e]; }
                *(u32x4*)(CQ + (size_t)m * 1024 + lane * 8) = pack8(a); *(u32x4*)(CQ + (size_t)m * 1024 + 512 + lane * 8) = pack8(b); }
            {
                float a[8]; unpack8(*(const u32x4*)(zr + Z_ZKV + lane * 8), a);
                float s = 0.f;
#pragma unroll
                for (int e = 0; e < 8; ++e) s += a[e] * a[e];
                const float rstd = rsqrtf(wave_sum(s) * (1.f / 512.f) + EPS);
#pragma unroll
                for (int e = 0; e < 8; ++e) a[e] *= rstd * gkv[lane * 8 + e];
                *(u32x4*)(CKV + (size_t)m * 512 + lane * 8) = pack8(a); }
            {
                const float x = bf_lo((unsigned)zr[Z_KR + lane]);
                const float rstd = rsqrtf(wave_sum(x * x) * (1.f / 64.f) + EPS);
                const float y = x * rstd * gkr[lane], yp = __shfl_xor(y, 32);
                const float ang = (float)pos[m] * c_inv_freq[lane & 31], cs = cosf(ang), sn = sinf(ang);
                const float o = (lane < 32) ? (y * cs - yp * sn) : (y * cs + yp * sn);
                KR[(size_t)m * 64 + lane] = (bf16_t)f2bf(o); }
            {
                const int t = m & (SEQ - 1);
#pragma unroll
                for (int g = 0; g < 4; ++g) { const int w = 2 << g; float acc[8], own[8];
                    unpack8(*(const u32x4*)(zr + Z_ZP + g * 512 + lane * 8), own);
#pragma unroll
                    for (int e = 0; e < 8; ++e) acc[e] = own[e];
                    const int nb = t < (w - 1) ? t : (w - 1);
                    for (int j = 1; j <= nb; ++j) { float v[8]; unpack8(*(const u32x4*)(zr - (size_t)j * ZW + Z_ZP + g * 512 + lane * 8), v);
#pragma unroll
                        for (int e = 0; e < 8; ++e) acc[e] += v[e]; }
                    const float inv = 1.0f / (float)(nb + 1);
#pragma unroll
                    for (int e = 0; e < 8; ++e) acc[e] = acc[e] * inv - own[e];
                    *(u32x4*)(PM + (size_t)m * 2048 + g * 512 + lane * 8) = pack8(acc); } }
        }
    }
    SEAM(5);
    if (IN(6)) {
        { pg8::Gemm g = pg8::mk_gemm(CQ, WUQ, 1024, 1024, 1024); pg8::StaticOrder S; S.init(M / 256, QW / 256, (int)gridDim.x, (int)blockIdx.x);
          pg8::EpiBf16S E{QB, QW, nullptr}; pg8::gemm_phase(LDSP, g, S, E); }
        { pg8::Gemm g = pg8::mk_gemm(CKV, WUKV, 512, 512, 512); pg8::StaticOrder S; S.init(M / 256, KVW / 256, (int)gridDim.x, (int)blockIdx.x);
          pg8::EpiBf16S E{KVB, KVW, nullptr}; pg8::gemm_phase(LDSP, g, S, E); }
        { pg8::Gemm g = pg8::mk_gemm(PM, WPOOL, 2048, 2048, 512); g.ashift = 1; g.astride = 512; g.bmask = 1; g.bstride = 512;
          pg8::StaticOrder S; S.init(M / 256, AW / 256, (int)gridDim.x, (int)blockIdx.x);
          pg8::EpiBf16S E{AO, AW, P.in[I_PSCALE]}; pg8::gemm_phase(LDSP, g, S, E); }
    }
    SEAM(6);
    if (IN(7)) {
        PHASE_IDS();
        const float* gqn = P.in[I_QNN]; const float* gkn = P.in[I_KNN]; const float* gqr = P.in[I_QRN]; const int* pos = (const int*)P.in[I_POS];
        for (int m = gw; m < M; m += NGW) {
            const float ang = (float)pos[m] * c_inv_freq[lane & 31], cs = cosf(ang), sn = sinf(ang);
            const int sub = lane & 15;
#pragma unroll
            for (int it = 0; it < 4; ++it) { const int head = 4 * it + (lane >> 4);
                { bf16_t* p = QB + (size_t)m * QW + head * 192 + sub * 8; float a[8]; unpack8(*(const u32x4*)p, a); float s = 0.f;
#pragma unroll
                  for (int e = 0; e < 8; ++e) s += a[e] * a[e];
                  s += __shfl_xor(s, 1); s += __shfl_xor(s, 2); s += __shfl_xor(s, 4); s += __shfl_xor(s, 8);
                  const float rstd = rsqrtf(s * (1.f / 128.f) + EPS) * QSCALE;
#pragma unroll
                  for (int e = 0; e < 8; ++e) a[e] *= rstd * gqn[sub * 8 + e];
                  *(u32x4*)p = pack8(a); }
                { bf16_t* p = KVB + (size_t)m * KVW + head * 256 + sub * 8; float a[8]; unpack8(*(const u32x4*)p, a); float s = 0.f;
#pragma unroll
                  for (int e = 0; e < 8; ++e) s += a[e] * a[e];
                  s += __shfl_xor(s, 1); s += __shfl_xor(s, 2); s += __shfl_xor(s, 4); s += __shfl_xor(s, 8);
                  const float rstd = rsqrtf(s * (1.f / 128.f) + EPS);
#pragma unroll
                  for (int e = 0; e < 8; ++e) a[e] *= rstd * gkn[sub * 8 + e];
                  *(u32x4*)p = pack8(a); } }
            const int j8 = lane & 7;
#pragma unroll
            for (int it = 0; it < 2; ++it) { const int head = 8 * it + (lane >> 3);
                bf16_t* p = QB + (size_t)m * QW + head * 192 + 128 + j8 * 8; float a[8]; unpack8(*(const u32x4*)p, a); float s = 0.f;
#pragma unroll
                for (int e = 0; e < 8; ++e) s += a[e] * a[e];
                s += __shfl_xor(s, 1); s += __shfl_xor(s, 2); s += __shfl_xor(s, 4);
                const float rstd = rsqrtf(s * (1.f / 64.f) + EPS);
                float o[8];
#pragma unroll
                for (int e = 0; e < 8; ++e) { const float y = a[e] * rstd * gqr[j8 * 8 + e], yp = __shfl_xor(y, 4); const int i = 8 * (j8 & 3) + e;
                    const float c = __shfl(cs, i), sv = __shfl(sn, i); o[e] = ((j8 < 4) ? (y * c - yp * sv) : (y * c + yp * sv)) * QSCALE; }
                *(u32x4*)p = pack8(o); }
        }
    }
    SEAM(7);
    if (IN(8)) {
        PHASE_IDS();
        const int r32 = lane & 31, hi5 = lane >> 5;
        for (int item = vcu_; item < 512; item += (int)gridDim.x) {
            const int bh = item >> 4, x = item & 15, b = bh >> 4, h = bh & 15;
#pragma unroll 1
            for (int half = 0; half < 2; ++half) {
                const int qb = half ? 31 - x : x;
                const size_t row0 = (size_t)b * SEQ + (size_t)qb * 256;
                bf16x8 qr[12];
                const bf16_t* Qw = QB + (row0 + wave_ * 32 + r32) * QW + h * 192 + hi5 * 8;
#pragma unroll
                for (int d0 = 0; d0 < 12; ++d0) qr[d0] = *(const bf16x8*)(Qw + d0 * 16);
                att::attn_unit<192, true>(qr, KVB + (size_t)b * SEQ * KVW + h * 256, KVW, KR + (size_t)b * SEQ * 64, 64, KVB + (size_t)b * SEQ * KVW + h * 256 + 128, KVW,
                                          BO + row0 * AW + h * 128, AW, 4 * (qb + 1), (char*)lds_raw);
            }
        }
    }
    SEAM(8);
    if (IN(9)) {
        pg8::Gemm g = pg8::mk_gemm(AO, WBP, AW, AW, AW); pg8::StaticOrder S; S.init(M / 256, D / 256, (int)gridDim.x, (int)blockIdx.x);
        pg8::EpiMerge<false> E{MG, D, Z + Z_GP, ZW}; pg8::gemm_phase(LDSP, g, S, E);
    }
    SEAM(9);
    if (IN(10)) {
        pg8::Gemm g = pg8::mk_gemm(BO, WBM, AW, AW, AW); pg8::StaticOrder S; S.init(M / 256, D / 256, (int)gridDim.x, (int)blockIdx.x);
        pg8::EpiMerge<true> E{MG, D, Z + Z_GM, ZW}; pg8::gemm_phase(LDSP, g, S, E);
    }
    SEAM(10);
    if (IN(11)) {
        pg8::Gemm g = pg8::mk_gemm(MG, WOUT, D, D, D); pg8::StaticOrder S; S.init(M / 256, D / 256, (int)gridDim.x, (int)blockIdx.x);
        pg8::EpiResF32 E{OUT, OUT, D, 1.0f}; pg8::gemm_phase(LDSP, g, S, E);
    }
    SEAM(11);
    if (IN(12)) {
        PHASE_IDS();
        for (int m = gw; m < M; m += NGW) rms_row_4096(OUT + (size_t)m * D, P.in[I_XNORM], XN + (size_t)m * D, lane);
        const float* gxk = P.in[I_XKN];
        for (int m = gw; m < MMEM; m += NGW) {
            const float* kr = XKV + (size_t)m * 1024 + lane * 8; const float* vr = kr + 512;
            const f32x4 k0 = *(const f32x4*)kr, k1 = *(const f32x4*)(kr + 4), v0 = *(const f32x4*)vr, v1 = *(const f32x4*)(vr + 4);
            float s = (k0.x * k0.x + k0.y * k0.y) + (k0.z * k0.z + k0.w * k0.w) + (k1.x * k1.x + k1.y * k1.y) + (k1.z * k1.z + k1.w * k1.w);
            s += __shfl_xor(s, 1); s += __shfl_xor(s, 2); s += __shfl_xor(s, 4); s += __shfl_xor(s, 8);
            const float rstd = rsqrtf(s * (1.f / 128.f) + EPS); const int c = (lane & 15) * 8;
            float a[8] = {k0.x * rstd * gxk[c], k0.y * rstd * gxk[c + 1], k0.z * rstd * gxk[c + 2], k0.w * rstd * gxk[c + 3], k1.x * rstd * gxk[c + 4], k1.y * rstd * gxk[c + 5], k1.z * rstd * gxk[c + 6], k1.w * rstd * gxk[c + 7]};
            float bb[8] = {v0.x, v0.y, v0.z, v0.w, v1.x, v1.y, v1.z, v1.w};
            *(u32x4*)(XKB + (size_t)m * 512 + lane * 8) = pack8(a); *(u32x4*)(XVB + (size_t)m * 512 + lane * 8) = pack8(bb);
        }
    }
    SEAM(12);
    if (IN(13)) {
        pg8::Gemm g = pg8::mk_gemm(XN, WXQ, D, D, 2048); g.ashift = 1; g.astride = 2048; g.bmask = 1; g.bstride = 2048;
        pg8::StaticOrder S; S.init(M / 256, 4, (int)gridDim.x, (int)blockIdx.x);
        pg8::EpiF32Split E{XQP, 512, 1, 1, (size_t)M * 512}; pg8::gemm_phase(LDSP, g, S, E);
    }
    SEAM(13);
    if (IN(14)) {
        PHASE_IDS();
        const int r32 = lane & 31, hi5 = lane >> 5; const float* gxq = P.in[I_XQN];
        for (int item = vcu_; item < 256; item += (int)gridDim.x) {
            const int bh = item >> 5, qb = item & 31, b = bh >> 2, h = bh & 3;
            const size_t row0 = (size_t)b * SEQ + (size_t)qb * 256;
            bf16x8 qr[8];
            { const float* q0 = XQP + (row0 + wave_ * 32 + r32) * 512 + h * 128 + hi5 * 8; const float* q1 = q0 + (size_t)M * 512;
              f32x4 qa[8], qbv[8]; float s = 0.f;
#pragma unroll
              for (int d0 = 0; d0 < 8; ++d0) { qa[d0] = *(const f32x4*)(q0 + d0 * 16) + *(const f32x4*)(q1 + d0 * 16); qbv[d0] = *(const f32x4*)(q0 + d0 * 16 + 4) + *(const f32x4*)(q1 + d0 * 16 + 4);
                  s += (qa[d0].x * qa[d0].x + qa[d0].y * qa[d0].y) + (qa[d0].z * qa[d0].z + qa[d0].w * qa[d0].w) + (qbv[d0].x * qbv[d0].x + qbv[d0].y * qbv[d0].y) + (qbv[d0].z * qbv[d0].z + qbv[d0].w * qbv[d0].w); }
              s += __shfl_xor(s, 32);
              const float rstd = rsqrtf(s * (1.f / 128.f) + EPS) * XSCALE;
#pragma unroll
              for (int d0 = 0; d0 < 8; ++d0) { const float* gp = gxq + d0 * 16 + hi5 * 8; const f32x4 g0 = *(const f32x4*)gp, g1 = *(const f32x4*)(gp + 4);
                  const f32x4 a = qa[d0] * rstd * g0, c = qbv[d0] * rstd * g1; u32x4 w; w.x = cvt_pk_bf16(a.x, a.y); w.y = cvt_pk_bf16(a.z, a.w); w.z = cvt_pk_bf16(c.x, c.y); w.w = cvt_pk_bf16(c.z, c.w);
                  qr[d0] = __builtin_bit_cast(bf16x8, w); } }
            att::attn_unit<128, false>(qr, XKB + (size_t)b * 256 * 512 + h * 128, 512, nullptr, 0, XVB + (size_t)b * 256 * 512 + h * 128, 512,
                                       XO + row0 * 512 + h * 128, 512, 4, (char*)lds_raw);
        }
    }
    SEAM(14);
    if (IN(15)) {
        pg8::Gemm g = pg8::mk_gemm(XO, WXO, 512, 512, 512); pg8::StaticOrder S; S.init(M / 256, D / 256, (int)gridDim.x, (int)blockIdx.x);
        pg8::EpiResF32 E{OUT, OUT, D, 1.0f}; pg8::gemm_phase(LDSP, g, S, E);
    }
    SEAM(15);
    if (IN(16)) {
        PHASE_IDS();
        for (int m = gw; m < M; m += NGW) rms_row_4096(OUT + (size_t)m * D, P.in[I_F2N], XN + (size_t)m * D, lane);
    }
    SEAM(16);
    if (IN(17)) {
        pg8::Gemm g = pg8::mk_gemm(XN, WGU, D, D, D); pg8::StaticOrder S; S.init(M / 256, FF / 128, (int)gridDim.x, (int)blockIdx.x);
        pg8::EpiSwiGLU E{HID, FF}; pg8::gemm_phase(LDSP, g, S, E);
    }
    SEAM(17);
    if (IN(18)) {
        pg8::Gemm g = pg8::mk_gemm(HID, WDN, FF, FF, FF); pg8::StaticOrder S; S.init(M / 256, D / 256, (int)gridDim.x, (int)blockIdx.x);
        pg8::EpiResF32 E{OUT, OUT, D, 0.5f}; pg8::gemm_phase(LDSP, g, S, E);
    }
#undef IN
#undef SEAM
#undef TRANSPOSE_JOB
}

extern "C" void kernel_launch(void* const* d_in, const int* in_sizes, int n_in, void* d_out, int out_size, void* d_ws, size_t ws_size, hipStream_t stream) {
    static int grid = 0;
    if (grid == 0) {
        if (n_in != N_IN || in_sizes[0] != M * D || out_size != M * D || ws_size < WS_END) {
            fprintf(stderr, "kernel_launch: unexpected shapes: n_in %d in0 %d out %d ws %zu (need %zu)\n", n_in, n_in > 0 ? in_sizes[0] : -1, out_size, ws_size, (size_t)WS_END); grid = -1; return; }
        int dev = 0, cus = 0;
        if (hipGetDevice(&dev) != hipSuccess || hipDeviceGetAttribute(&cus, hipDeviceAttributeMultiprocessorCount, dev) != hipSuccess) { grid = -1; return; }
        if (hipFuncSetAttribute((const void*)mk_fwd, hipFuncAttributeMaxDynamicSharedMemorySize, LDS_BYTES) != hipSuccess) { fprintf(stderr, "kernel_launch: hipFuncSetAttribute failed\n"); grid = -1; return; }
        int per_cu = 0;
        if (hipOccupancyMaxActiveBlocksPerMultiprocessor(&per_cu, (const void*)mk_fwd, NWAVES * 64, LDS_BYTES) != hipSuccess || per_cu < 1) { fprintf(stderr, "kernel_launch: occupancy query says %d\n", per_cu); }
        (void)hipGetLastError();
        grid = cus;
    }
    if (grid < 0) return;
    (void)hipMemsetAsync((char*)d_ws + WS_CTL, 0, CTL_ZERO_BYTES, stream);
    Params p{};
    for (int i = 0; i < N_IN; ++i) p.in[i] = (const float*)d_in[i];
    p.out = (float*)d_out; p.ws = (unsigned char*)d_ws;
#if MK_ONE_LAUNCH
    p.ph_lo = 0; p.ph_hi = N_PHASES;
    hipLaunchKernelGGL(mk_fwd, dim3(grid), dim3(NWAVES * 64), LDS_BYTES, stream, p);
#else
    for (int k = 0; k < N_PHASES; ++k) { p.ph_lo = k; p.ph_hi = k + 1; hipLaunchKernelGGL(mk_fwd, dim3(grid), dim3(NWAVES * 64), LDS_BYTES, stream, p); }
#endif
    const hipError_t le = hipPeekAtLastError();
    if (le != hipSuccess) fprintf(stderr, "kernel_launch: launch failed: %s\n", hipGetErrorName(le));
}
```

```cpp
#include <hip/hip_runtime.h>
#include <cstdio>
#include <cstdint>

#ifndef MK_ONE_LAUNCH
#define MK_ONE_LAUNCH 1
#endif

#define LAS __attribute__((address_space(3)))
#define GAS __attribute__((address_space(1)))
typedef unsigned short bf16_t;
typedef short bf16x8 __attribute__((ext_vector_type(8)));
typedef short s16x4 __attribute__((ext_vector_type(4)));
typedef float f32x2 __attribute__((ext_vector_type(2)));
typedef float f32x4 __attribute__((ext_vector_type(4)));
typedef float f32x16 __attribute__((ext_vector_type(16)));
typedef unsigned u32x2 __attribute__((ext_vector_type(2)));
typedef unsigned u32x4 __attribute__((ext_vector_type(4)));

constexpr int D = 4096, SEQ = 8192, M = 16384, MMEM = 512, FF = 11008;
constexpr int ZW = 12032;
constexpr int Z_ZP = 0, Z_ZQ = 2048, Z_ZKV = 3072, Z_GP = 3584, Z_GM = 7680, Z_KR = 11776;
constexpr int NH = 16, QW = 3072, KVW = 4096, AW = 2048;
constexpr float EPS = 1e-6f;
constexpr float LOG2E = 1.4426950408889634f;
constexpr float QSCALE = 0.07216878364870323f * LOG2E;
constexpr float XSCALE = 0.08838834764831845f * LOG2E;

constexpr size_t MiB = 1u << 20;
constexpr size_t WS_CTL = 0, CTL_ZERO_BYTES = 1 * MiB;
constexpr size_t WS_WGU = 1 * MiB, WS_WDN = 173 * MiB, WS_WIN = 259 * MiB, WS_WPOOL = 353 * MiB, WS_WUQ = 355 * MiB, WS_WUKV = 361 * MiB,
                 WS_WBP = 365 * MiB, WS_WBM = 381 * MiB, WS_WOUT = 397 * MiB, WS_WXQ = 429 * MiB, WS_WXKV = 433 * MiB, WS_WXO = 441 * MiB;
constexpr size_t WS_XN = 445 * MiB, WS_MN = 573 * MiB, WS_XKV = 577 * MiB, WS_XKB = 579 * MiB, WS_XVB = 579 * MiB + 512 * 1024;
constexpr size_t WS_R = 580 * MiB;
constexpr size_t WS_HID = WS_R, WS_Z = WS_R, WS_CQ = WS_R + 376 * MiB, WS_CKV = WS_R + 408 * MiB, WS_KR = WS_R + 424 * MiB, WS_PM = WS_R + 426 * MiB,
                 WS_Q = WS_R + 490 * MiB, WS_KV = WS_R + 586 * MiB, WS_AO = WS_R + 714 * MiB, WS_BO = WS_R + 778 * MiB, WS_END = WS_R + 842 * MiB;
constexpr size_t WS_XQP = WS_R, WS_XO = WS_R + 64 * MiB, WS_UQ = WS_R + 80 * MiB;
constexpr size_t WS_SS = 64 * 1024;
constexpr int CW_BAR = 4096;

constexpr int RING_BYTES = 131072, LDSCTL_OFF = 135168, MISC_OFF = LDSCTL_OFF + 320, LDS_BYTES = 147456;

__device__ __forceinline__ unsigned cvt_pk_bf16(float lo, float hi) { unsigned r; asm volatile("v_cvt_pk_bf16_f32 %0, %1, %2" : "=v"(r) : "v"(lo), "v"(hi)); return r; }
__device__ __forceinline__ float bf_lo(unsigned u) { return __builtin_bit_cast(float, u << 16); }
__device__ __forceinline__ float bf_hi(unsigned u) { return __builtin_bit_cast(float, u & 0xffff0000u); }
__device__ __forceinline__ float sigmoidf_(float x) { return __builtin_amdgcn_rcpf(1.0f + __builtin_amdgcn_exp2f(-x * LOG2E)); }

namespace pg8 {
constexpr int BM = 256, BK = 64, HALF = 128, HTB = HALF * BK * 2, STAGE_BYTES = 8 * HTB, NXCD = 8, WGM = 8;
__host__ __device__ __forceinline__ int lds_byte(int r, int c) { const int st = (r >> 4) * 2 + (c >> 5), rr = r & 15, cc = c & 31, ob = rr * 64 + cc * 2; return st * 1024 + (ob ^ (((ob >> 9) & 1) << 5)); }
__host__ __device__ __forceinline__ void stage_rc(int b, int& R, int& C) { const int st = b / 1024, sb = b % 1024, swz = sb ^ (((sb >> 9) & 1) << 5); R = (st >> 1) * 16 + swz / 64; C = (st & 1) * 32 + (swz % 64) / 2; }
__host__ __device__ __forceinline__ int perm32(int rho) { const int n = rho >> 4, i = rho & 15; return 8 * (i >> 2) + 4 * n + (i & 3); }

struct Unit { int pm, pn; };
struct Gemm { const bf16_t* A; const bf16_t* Bt; int lda, ldb, K; int ashift, astride, bmask, bstride; };
__device__ __forceinline__ Gemm mk_gemm(const bf16_t* A, const bf16_t* Bt, int lda, int ldb, int K) { Gemm g; g.A = A; g.Bt = Bt; g.lda = lda; g.ldb = ldb; g.K = K; g.ashift = 30; g.astride = 0; g.bmask = 0x7fffffff; g.bstride = 0; return g; }

struct StaticOrder {
    int nM, nN, nwg, G, c;
    __host__ __device__ void init(int nM_, int nN_, int G_, int c_) { nM = nM_; nN = nN_; nwg = nM * nN; G = G_; c = c_; }
    __host__ __device__ bool next(int i, Unit& u) const {
        const long L = (long)i * G + c; if (L >= nwg) return false;
        int wgid = (int)L; { const int q = nwg / NXCD, r = nwg % NXCD, xcd = wgid % NXCD, off = wgid / NXCD; wgid = (xcd < r ? xcd * (q + 1) : r * (q + 1) + (xcd - r) * q) + off; }
        const int nig = WGM * nN, gid = wgid / nig, fm = gid * WGM, gsz = (nM - fm) < WGM ? (nM - fm) : WGM;
        u.pm = fm + ((wgid % nig) % gsz); u.pn = (wgid % nig) / gsz; return true;
    }
};

__device__ __forceinline__ float row_rstd(const float* rowss, int row) { return rowss ? rsqrtf(rowss[row] * (1.f / 4096.f) + 1e-6f) : 1.f; }
struct EpiSwiGLU {
    static constexpr bool PERM = true;
    bf16_t* H; int ldh; const float* rowss;
    __device__ __forceinline__ void operator()(const f32x4 (&acc)[2][2][4][2], const Unit& u, int wr, int wc, int fr, int fq) const {
        const int row0 = u.pm * BM + wr * 64 + fr, col0 = u.pn * HALF + wc * 32 + 8 * fq;
#pragma unroll
        for (int ai = 0; ai < 2; ++ai)
#pragma unroll
            for (int m = 0; m < 4; ++m) {
                const int row = row0 + ai * HALF + m * 16; const float rs = row_rstd(rowss, row);
                float h[8];
#pragma unroll
                for (int n = 0; n < 2; ++n)
#pragma unroll
                    for (int e = 0; e < 4; ++e) { const float g = acc[ai][0][m][n][e] * rs, up = acc[ai][1][m][n][e] * rs; h[n * 4 + e] = g * sigmoidf_(g) * up; }
                u32x4 w; w.x = cvt_pk_bf16(h[0], h[1]); w.y = cvt_pk_bf16(h[2], h[3]); w.z = cvt_pk_bf16(h[4], h[5]); w.w = cvt_pk_bf16(h[6], h[7]);
                *(u32x4*)(H + (size_t)row * ldh + col0) = w; }
    }
};
template <bool NORM> struct EpiRes {
    static constexpr bool PERM = false;
    const float* base; float* out; int ldc; float alpha; bf16_t* xn; const float* gain; float* rowss;
    __device__ __forceinline__ void operator()(const f32x4 (&acc)[2][2][4][2], const Unit& u, int wr, int wc, int fr, int fq) const {
        const int row0 = u.pm * BM + wr * 64 + fr, col0 = u.pn * BM + wc * 32 + 4 * fq;
        f32x4 gv[2][2];
        if (NORM) {
#pragma unroll
            for (int bj = 0; bj < 2; ++bj)
#pragma unroll
                for (int n = 0; n < 2; ++n) gv[bj][n] = *(const f32x4*)(gain + col0 + bj * HALF + n * 16); }
#pragma unroll
        for (int ai = 0; ai < 2; ++ai)
#pragma unroll
            for (int m = 0; m < 4; ++m) { const int row = row0 + ai * HALF + m * 16; const size_t off = (size_t)row * ldc + col0; float s = 0.f;
#pragma unroll
                for (int bj = 0; bj < 2; ++bj)
#pragma unroll
                    for (int n = 0; n < 2; ++n) { const f32x4 b = *(const f32x4*)(base + off + bj * HALF + n * 16); const f32x4 h = b + acc[ai][bj][m][n] * alpha; *(f32x4*)(out + off + bj * HALF + n * 16) = h;
                        if (NORM) { s += (h.x * h.x + h.y * h.y) + (h.z * h.z + h.w * h.w); const f32x4 y = h * gv[bj][n]; u32x2 w; w.x = cvt_pk_bf16(y.x, y.y); w.y = cvt_pk_bf16(y.z, y.w); *(u32x2*)(xn + off + bj * HALF + n * 16) = w; } }
                if (NORM) { s += __shfl_xor(s, 16); s += __shfl_xor(s, 32); if (fq == 0) atomicAdd(rowss + row, s); } }
    }
};
struct EpiBf16S {
    static constexpr bool PERM = true;
    bf16_t* O; int ldc; const float* colscale; const float* rowss;
    __device__ __forceinline__ void operator()(const f32x4 (&acc)[2][2][4][2], const Unit& u, int wr, int wc, int fr, int fq) const {
        const int row0 = u.pm * BM + wr * 64 + fr, col0 = u.pn * BM + wc * 32 + 8 * fq;
        f32x4 sv[2][2];
#pragma unroll
        for (int bj = 0; bj < 2; ++bj)
#pragma unroll
            for (int n = 0; n < 2; ++n) sv[bj][n] = colscale ? *(const f32x4*)(colscale + col0 + bj * HALF + 4 * n) : (f32x4){1.f, 1.f, 1.f, 1.f};
#pragma unroll
        for (int ai = 0; ai < 2; ++ai)
#pragma unroll
            for (int m = 0; m < 4; ++m) { const int row = row0 + ai * HALF + m * 16; const float rs = row_rstd(rowss, row); bf16_t* rowp = O + (size_t)row * ldc + col0;
#pragma unroll
                for (int bj = 0; bj < 2; ++bj) { const f32x4 v0 = acc[ai][bj][m][0] * sv[bj][0] * rs, v1 = acc[ai][bj][m][1] * sv[bj][1] * rs;
                    u32x4 w; w.x = cvt_pk_bf16(v0[0], v0[1]); w.y = cvt_pk_bf16(v0[2], v0[3]); w.z = cvt_pk_bf16(v1[0], v1[1]); w.w = cvt_pk_bf16(v1[2], v1[3]);
                    *(u32x4*)(rowp + bj * HALF) = w; } }
    }
};
template <bool ADD> struct EpiMerge {
    static constexpr bool PERM = true;
    bf16_t* O; int ldc; const bf16_t* gate; int ldg;
    __device__ __forceinline__ void operator()(const f32x4 (&acc)[2][2][4][2], const Unit& u, int wr, int wc, int fr, int fq) const {
        const int row0 = u.pm * BM + wr * 64 + fr, col0 = u.pn * BM + wc * 32 + 8 * fq;
#pragma unroll
        for (int ai = 0; ai < 2; ++ai)
#pragma unroll
            for (int m = 0; m < 4; ++m) { const size_t r = (size_t)(row0 + ai * HALF + m * 16);
#pragma unroll
                for (int bj = 0; bj < 2; ++bj) {
                    const u32x4 gv = *(const u32x4*)(gate + r * ldg + col0 + bj * HALF);
                    u32x4 ov = (u32x4){0u, 0u, 0u, 0u}; if (ADD) ov = *(const u32x4*)(O + r * ldc + col0 + bj * HALF);
                    const f32x4 a0 = acc[ai][bj][m][0], a1 = acc[ai][bj][m][1];
                    float v[8];
                    v[0] = sigmoidf_(bf_lo(gv.x)) * a0[0]; v[1] = sigmoidf_(bf_hi(gv.x)) * a0[1]; v[2] = sigmoidf_(bf_lo(gv.y)) * a0[2]; v[3] = sigmoidf_(bf_hi(gv.y)) * a0[3];
                    v[4] = sigmoidf_(bf_lo(gv.z)) * a1[0]; v[5] = sigmoidf_(bf_hi(gv.z)) * a1[1]; v[6] = sigmoidf_(bf_lo(gv.w)) * a1[2]; v[7] = sigmoidf_(bf_hi(gv.w)) * a1[3];
                    if (ADD) { v[0] += bf_lo(ov.x); v[1] += bf_hi(ov.x); v[2] += bf_lo(ov.y); v[3] += bf_hi(ov.y); v[4] += bf_lo(ov.z); v[5] += bf_hi(ov.z); v[6] += bf_lo(ov.w); v[7] += bf_hi(ov.w); }
                    u32x4 w; w.x = cvt_pk_bf16(v[0], v[1]); w.y = cvt_pk_bf16(v[2], v[3]); w.z = cvt_pk_bf16(v[4], v[5]); w.w = cvt_pk_bf16(v[6], v[7]);
                    *(u32x4*)(O + r * ldc + col0 + bj * HALF) = w; } }
    }
};
struct EpiF32Split {
    static constexpr bool PERM = false;
    float* O; int ldc; int tmask, tshift; size_t sstride; const float* rowss;
    __device__ __forceinline__ void operator()(const f32x4 (&acc)[2][2][4][2], const Unit& u, int wr, int wc, int fr, int fq) const {
        float* base = O + (size_t)(u.pn >> tshift) * sstride;
        const int row0 = u.pm * BM + wr * 64 + fr, col0 = (u.pn & tmask) * BM + wc * 32 + 4 * fq;
#pragma unroll
        for (int ai = 0; ai < 2; ++ai)
#pragma unroll
            for (int m = 0; m < 4; ++m) { const int row = row0 + ai * HALF + m * 16; const float rs = row_rstd(rowss, row); float* rowp = base + (size_t)row * ldc + col0;
#pragma unroll
                for (int bj = 0; bj < 2; ++bj)
#pragma unroll
                    for (int n = 0; n < 2; ++n) *(f32x4*)(rowp + bj * HALF + n * 16) = acc[ai][bj][m][n] * rs; }
    }
};

template <class Epi, class Sched, bool ALIGN_EPI = true>
__device__ __forceinline__ void gemm_phase(LAS unsigned char* lds, const Gemm g, const Sched& S, const Epi& E) {
    int tid = threadIdx.x; asm volatile("" : "+v"(tid));
    const int wid = __builtin_amdgcn_readfirstlane(tid >> 6), lane = tid & 63, wr = wid >> 2, wc = wid & 3, fr = lane & 15, fq = lane >> 4;
    const int K = g.K, nt = K / BK;
    unsigned voffA[2], voffB[2];
#pragma unroll
    for (int i = 0; i < 2; ++i) { int R, C; stage_rc(tid * 16 + i * 8192, R, C); const int Rb = Epi::PERM ? ((R & ~31) + perm32(R & 31)) : R;
        voffA[i] = (unsigned)(R * g.lda + C) * 2u; voffB[i] = (unsigned)(Rb * g.ldb + C) * 2u; }
    const size_t kstep = (size_t)(BK * 2);
    const size_t hstepA = (size_t)HALF * g.lda * 2, hstepB = (size_t)HALF * g.ldb * 2;
    const unsigned ldsw = (unsigned)wid * 1024u;
    const int aoff = lds_byte(wr * 64 + fr, fq * 8), boff = lds_byte(wc * 32 + fr, fq * 8);
#define PG8_SA(b, h) (((b) * 2 + (h)) * HTB)
#define PG8_SB(b, h) ((4 + (b) * 2 + (h)) * HTB)
#define PG8_STAGE(bufoff, gbase, voff) do { _Pragma("unroll") for (int _i = 0; _i < 2; ++_i) \
        __builtin_amdgcn_global_load_lds((const unsigned*)((const char*)(gbase) + (voff)[_i]), (LAS unsigned*)(lds + (bufoff) + ldsw + _i * 8192), 16, 0, 0); } while (0)
#define PG8_LDA(dst, b, h) do { _Pragma("unroll") for (int m = 0; m < 4; ++m) _Pragma("unroll") for (int k = 0; k < 2; ++k) dst[m][k] = *(const LAS bf16x8*)(lds + PG8_SA(b, h) + aoff + m * 2048 + k * 1024); } while (0)
#define PG8_LDB(dst, b, h) do { _Pragma("unroll") for (int n = 0; n < 2; ++n) _Pragma("unroll") for (int k = 0; k < 2; ++k) dst[n][k] = *(const LAS bf16x8*)(lds + PG8_SB(b, h) + boff + n * 2048 + k * 1024); } while (0)
#define PG8_MMA(ai, bj, At, Bt) do { __builtin_amdgcn_s_setprio(1); _Pragma("unroll") for (int m = 0; m < 4; ++m) _Pragma("unroll") for (int n = 0; n < 2; ++n) _Pragma("unroll") for (int k = 0; k < 2; ++k) \
        acc[ai][bj][m][n] = __builtin_amdgcn_mfma_f32_16x16x32_bf16(Bt[n][k], At[m][k], acc[ai][bj][m][n], 0, 0, 0); __builtin_amdgcn_s_setprio(0); } while (0)
#define PG8_WAIT_V(n) asm volatile("s_waitcnt vmcnt(" #n ")" ::: "memory")
#define PG8_WAIT_L(n) asm volatile("s_waitcnt lgkmcnt(" #n ")" ::: "memory")
#define PG8_BAR __builtin_amdgcn_s_barrier()
#define PG8_SCHED __builtin_amdgcn_sched_barrier(0)
#define PG8_APTR(u) ((const char*)g.A + ((size_t)(u).pm * BM * g.lda + (size_t)((u).pn >> g.ashift) * g.astride) * 2)
#define PG8_BPTR(u) ((const char*)g.Bt + ((size_t)((u).pn & g.bmask) * BM * g.ldb + (size_t)((u).pn >> g.ashift) * g.bstride) * 2)
    Unit cur, nxt; int ui = 0;
    if (!S.next(0, cur)) return;
    f32x4 acc[2][2][4][2];
#pragma unroll
    for (int a = 0; a < 2; ++a)
#pragma unroll
        for (int b = 0; b < 2; ++b)
#pragma unroll
            for (int m = 0; m < 4; ++m)
#pragma unroll
                for (int n = 0; n < 2; ++n) acc[a][b][m][n] = (f32x4){0.f, 0.f, 0.f, 0.f};
    bf16x8 At[4][2], B0[2][2], B1[2][2];
    const char* cA = PG8_APTR(cur); const char* cB = PG8_BPTR(cur);
    PG8_STAGE(PG8_SB(0, 0), cB, voffB); PG8_STAGE(PG8_SB(0, 1), cB + hstepB, voffB); PG8_STAGE(PG8_SA(0, 0), cA, voffA); PG8_STAGE(PG8_SA(0, 1), cA + hstepA, voffA);
    if (wr == 1) PG8_BAR;
    PG8_WAIT_V(2); PG8_BAR;
    PG8_STAGE(PG8_SB(1, 0), cB + kstep, voffB); PG8_STAGE(PG8_SA(1, 0), cA + kstep, voffA); PG8_STAGE(PG8_SB(1, 1), cB + hstepB + kstep, voffB);
    PG8_WAIT_V(6); PG8_BAR;
    for (;;) {
        const bool has_next = S.next(ui + 1, nxt);
        const char* nA = has_next ? PG8_APTR(nxt) : cA; const char* nB = has_next ? PG8_BPTR(nxt) : cB;
        for (int t = 0; t < nt; t += 2) {
            const bool last = (t == nt - 2);
            const char* a1 = cA + (size_t)(t + 1) * kstep;
            const char* a2 = last ? nA : cA + (size_t)(t + 2) * kstep; const char* b2 = last ? nB : cB + (size_t)(t + 2) * kstep;
            const char* a3 = a2 + kstep; const char* b3 = b2 + kstep;
            PG8_LDB(B0, 0, 0); PG8_LDB(B1, 0, 1); PG8_SCHED; PG8_LDA(At, 0, 0); PG8_STAGE(PG8_SA(1, 1), a1 + hstepA, voffA);
            PG8_WAIT_V(8); PG8_WAIT_L(0); PG8_BAR; PG8_MMA(0, 0, At, B0); PG8_MMA(0, 1, At, B1); PG8_BAR; PG8_SCHED;
            PG8_LDA(At, 0, 1); PG8_STAGE(PG8_SB(0, 0), b2, voffB); PG8_STAGE(PG8_SB(0, 1), b2 + hstepB, voffB); PG8_STAGE(PG8_SA(0, 0), a2, voffA);
            PG8_WAIT_V(8); PG8_WAIT_L(0); PG8_BAR; PG8_MMA(1, 0, At, B0); PG8_MMA(1, 1, At, B1); PG8_BAR; PG8_SCHED;
            PG8_LDB(B0, 1, 0); PG8_LDB(B1, 1, 1); PG8_SCHED; PG8_LDA(At, 1, 0); PG8_STAGE(PG8_SA(0, 1), a2 + hstepA, voffA);
            PG8_WAIT_V(8); PG8_WAIT_L(0); PG8_BAR; PG8_MMA(0, 0, At, B0); PG8_MMA(0, 1, At, B1); PG8_BAR; PG8_SCHED;
            PG8_LDA(At, 1, 1); PG8_STAGE(PG8_SB(1, 0), b3, voffB); PG8_STAGE(PG8_SB(1, 1), b3 + hstepB, voffB); PG8_STAGE(PG8_SA(1, 0), a3, voffA);
            PG8_WAIT_V(8); PG8_WAIT_L(0); PG8_BAR; PG8_MMA(1, 0, At, B0); PG8_MMA(1, 1, At, B1); PG8_BAR; PG8_SCHED;
        }
        if constexpr (ALIGN_EPI) { if (wr == 0) PG8_BAR; }
        E(acc, cur, wr, wc, fr, fq);
        if (!has_next) break;
#pragma unroll
        for (int a = 0; a < 2; ++a)
#pragma unroll
            for (int b = 0; b < 2; ++b)
#pragma unroll
                for (int m = 0; m < 4; ++m)
#pragma unroll
                    for (int n = 0; n < 2; ++n) acc[a][b][m][n] = (f32x4){0.f, 0.f, 0.f, 0.f};
        cur = nxt; cA = nA; cB = nB; ++ui;
        if constexpr (ALIGN_EPI) { if (wr == 1) PG8_BAR; }
    }
    PG8_WAIT_V(0);
    if constexpr (!ALIGN_EPI) { if (wr == 0) PG8_BAR; }
    PG8_BAR;
#undef PG8_SA
#undef PG8_SB
#undef PG8_STAGE
#undef PG8_LDA
#undef PG8_LDB
#undef PG8_MMA
#undef PG8_WAIT_V
#undef PG8_WAIT_L
#undef PG8_BAR
#undef PG8_SCHED
#undef PG8_APTR
#undef PG8_BPTR
}
}

namespace att {
constexpr int KVBLK = 64, QBLK = 32, NW = 8;
constexpr int SHM_V = KVBLK * 128 * 2;
constexpr float THR2 = 11.5f;
#define ATT_KSWZ(row, colB, KROW) ((row) * (KROW) + (colB))
#define ATT_SBAR() __builtin_amdgcn_sched_barrier(0)
__device__ __forceinline__ int crow(int r, int hi) { return (r & 3) + 8 * (r >> 2) + 4 * hi; }

__device__ __forceinline__ void partialSM(f32x16& p0, f32x16& p1, float& m_reg, float& mn, float& alpha) {
    float pmax = p0[0];
#pragma unroll
    for (int r = 1; r < 16; ++r) pmax = fmaxf(pmax, p0[r]);
#pragma unroll
    for (int r = 0; r < 16; ++r) pmax = fmaxf(pmax, p1[r]);
    { auto rr = __builtin_amdgcn_permlane32_swap(__float_as_uint(pmax), __float_as_uint(pmax), false, false);
      pmax = fmaxf(__uint_as_float(rr[0]), __uint_as_float(rr[1])); }
    if (__builtin_expect(__all(pmax - m_reg <= THR2), 1)) { mn = m_reg; alpha = 1.f; }
    else { mn = fmaxf(m_reg, pmax); alpha = __builtin_amdgcn_exp2f(m_reg - mn); m_reg = mn; }
#pragma unroll
    for (int r = 0; r < 16; ++r) p0[r] = p0[r] - mn;
#pragma unroll
    for (int r = 0; r < 16; ++r) p1[r] = p1[r] - mn;
#pragma unroll
    for (int r = 0; r < 16; ++r) p0[r] = __builtin_amdgcn_exp2f(p0[r]);
}
__device__ __forceinline__ void finishSM(f32x16& p0, f32x16& p1, float alpha, float& l_reg, bf16x8& pa0, bf16x8& pa1, bf16x8& pa2, bf16x8& pa3) {
#pragma unroll
    for (int r = 0; r < 16; ++r) p1[r] = __builtin_amdgcn_exp2f(p1[r]);
    float ps = 0;
#pragma unroll
    for (int r = 0; r < 16; ++r) ps += p0[r];
#pragma unroll
    for (int r = 0; r < 16; ++r) ps += p1[r];
    { auto rr = __builtin_amdgcn_permlane32_swap(__float_as_uint(ps), __float_as_uint(ps), false, false);
      ps = __uint_as_float(rr[0]) + __uint_as_float(rr[1]); }
    l_reg = l_reg * alpha + ps;
#define ATT_PK4(P, BASE, OUT) do { unsigned a0 = cvt_pk_bf16(P[BASE + 0], P[BASE + 1]), a1 = cvt_pk_bf16(P[BASE + 2], P[BASE + 3]);   \
    unsigned b0 = cvt_pk_bf16(P[BASE + 4], P[BASE + 5]), b1 = cvt_pk_bf16(P[BASE + 6], P[BASE + 7]);                              \
    auto r0 = __builtin_amdgcn_permlane32_swap(a0, b0, false, false); auto r1 = __builtin_amdgcn_permlane32_swap(a1, b1, false, false); \
    u32x4 w = {r0[0], r1[0], r0[1], r1[1]}; OUT = __builtin_bit_cast(bf16x8, w); } while (0)
    ATT_PK4(p0, 0, pa0); ATT_PK4(p0, 8, pa1); ATT_PK4(p1, 0, pa2); ATT_PK4(p1, 8, pa3);
#undef ATT_PK4
}
template <int DK> __device__ __forceinline__ void qkt(f32x16& p0, f32x16& p1, const char* Ks, const bf16x8* qr, int r32, int hi) {
    p0 = f32x16{}; p1 = f32x16{};
#pragma unroll
    for (int d0 = 0; d0 < DK / 16; ++d0) { const int cb = (d0 * 16 + hi * 8) * 2;
        const bf16x8 b0 = *reinterpret_cast<const bf16x8*>(Ks + ATT_KSWZ(r32, cb, DK * 2 + 16));
        const bf16x8 b1 = *reinterpret_cast<const bf16x8*>(Ks + ATT_KSWZ(32 + r32, cb, DK * 2 + 16));
        p0 = __builtin_amdgcn_mfma_f32_32x32x16_bf16(b0, qr[d0], p0, 0, 0, 0);
        p1 = __builtin_amdgcn_mfma_f32_32x32x16_bf16(b1, qr[d0], p1, 0, 0, 0); }
}
__device__ __forceinline__ void cmask(f32x16& p0, f32x16& p1, int t, int qrel, int hi) {
    const float ninf = -__builtin_inff();
#pragma unroll
    for (int r = 0; r < 16; ++r) { const int k0 = 64 * t + crow(r, hi); if (k0 > qrel) p0[r] = ninf; if (k0 + 32 > qrel) p1[r] = ninf; }
}
__device__ __forceinline__ int v_st(int k, int c) { const int kk = (k & ~0xC) | ((k & 4) << 1) | ((k & 8) >> 1); return ((kk >> 3) * 4 + (c >> 5)) * 512 + ((kk & 7) * 32 + (c & 31)) * 2; }
__device__ __forceinline__ int v_rd_base(int lane) { return ((lane & 3) << 3) | (((lane >> 2) & 3) << 6) | (((lane >> 4) & 1) << 5) | (((lane >> 5) & 1) << 8); }
constexpr int v_rd_off(int d0, int ks, int half) { return d0 * 512 + ks * 4096 + half * 2048; }
template <int OFF> __device__ __forceinline__ s16x4 tr_read(int vb) {
    s16x4 r; asm volatile("ds_read_b64_tr_b16 %0, %1 offset:%2" : "=&v"(r) : "v"(vb), "i"(OFF) : "memory"); return r;
}
template <int D0> __device__ __forceinline__ void pv_one(f32x16& od, int vb, bf16x8 pa0, bf16x8 pa1, bf16x8 pa2, bf16x8 pa3) {
    const s16x4 l0 = tr_read<v_rd_off(D0, 0, 0)>(vb), h0 = tr_read<v_rd_off(D0, 0, 1)>(vb), l1 = tr_read<v_rd_off(D0, 1, 0)>(vb), h1 = tr_read<v_rd_off(D0, 1, 1)>(vb);
    const s16x4 l2 = tr_read<v_rd_off(D0, 2, 0)>(vb), h2 = tr_read<v_rd_off(D0, 2, 1)>(vb), l3 = tr_read<v_rd_off(D0, 3, 0)>(vb), h3 = tr_read<v_rd_off(D0, 3, 1)>(vb);
    asm volatile("s_waitcnt lgkmcnt(0)" ::: "memory"); ATT_SBAR();
#define ATT_PK(L, H) (bf16x8){L[0], L[1], L[2], L[3], H[0], H[1], H[2], H[3]}
    od = __builtin_amdgcn_mfma_f32_32x32x16_bf16(pa0, ATT_PK(l0, h0), od, 0, 0, 0);
    od = __builtin_amdgcn_mfma_f32_32x32x16_bf16(pa1, ATT_PK(l1, h1), od, 0, 0, 0);
    od = __builtin_amdgcn_mfma_f32_32x32x16_bf16(pa2, ATT_PK(l2, h2), od, 0, 0, 0);
    od = __builtin_amdgcn_mfma_f32_32x32x16_bf16(pa3, ATT_PK(l3, h3), od, 0, 0, 0);
#undef ATT_PK
}
__device__ __forceinline__ void pv_d0(f32x16* o, int vb, bf16x8 pa0, bf16x8 pa1, bf16x8 pa2, bf16x8 pa3) {
    pv_one<0>(o[0], vb, pa0, pa1, pa2, pa3); pv_one<1>(o[1], vb, pa0, pa1, pa2, pa3); pv_one<2>(o[2], vb, pa0, pa1, pa2, pa3); pv_one<3>(o[3], vb, pa0, pa1, pa2, pa3);
}

template <int DK, bool CAUSAL>
__device__ __forceinline__ void attn_unit(const bf16x8 (&qr)[DK / 16], const bf16_t* __restrict__ Kn, int ldk, const bf16_t* __restrict__ Kr, int ldkr,
                                          const bf16_t* __restrict__ V, int ldv, bf16_t* __restrict__ O, int ldo, int NT, char* lds) {
    constexpr int KROW = DK * 2 + 16, SHM_K = KVBLK * KROW;
    int tid = threadIdx.x; asm volatile("" : "+v"(tid));
    const int wid = tid >> 6, lane = tid & 63, r32 = lane & 31, hi = lane >> 5;
    char* V_lds = lds; char* K_lds = lds + 2 * SHM_V;
    float* wsf = (float*)(lds + 2 * SHM_V + 2 * SHM_K) + wid * 64; float* li_l = wsf; float* al_l = wsf + 32;
    float m_reg = -1e30f, l_reg = 0; f32x16 o[4] = {};
    const int sr = tid >> 4, sc = (tid & 15) * 8, vst0 = v_st(sr, sc), vst1 = v_st(32 + sr, sc);
    const int rr = tid >> 3, rc = (tid & 7) * 8;
    const int vb0 = (int)(uintptr_t)V_lds + v_rd_base(lane);
    bf16x8 vs0, vs1, ks0, ks1, kr0;
#define SLOAD(k0) do { vs0 = *(const bf16x8*)(V + (size_t)((k0) + sr) * ldv + sc); vs1 = *(const bf16x8*)(V + (size_t)((k0) + 32 + sr) * ldv + sc); \
    ks0 = *(const bf16x8*)(Kn + (size_t)((k0) + sr) * ldk + sc); ks1 = *(const bf16x8*)(Kn + (size_t)((k0) + 32 + sr) * ldk + sc); \
    if constexpr (DK == 192) kr0 = *(const bf16x8*)(Kr + (size_t)((k0) + rr) * ldkr + rc); } while (0)
#define SWRITE(b) do { *(bf16x8*)(V_lds + (b) * SHM_V + vst0) = vs0; *(bf16x8*)(V_lds + (b) * SHM_V + vst1) = vs1; const int kc = sc * 2; \
    *(bf16x8*)(K_lds + (b) * SHM_K + ATT_KSWZ(sr, kc, KROW)) = ks0; *(bf16x8*)(K_lds + (b) * SHM_K + ATT_KSWZ(32 + sr, kc, KROW)) = ks1; \
    if constexpr (DK == 192) *(bf16x8*)(K_lds + (b) * SHM_K + ATT_KSWZ(rr, 256 + rc * 2, KROW)) = kr0; } while (0)
#define SWAIT() asm volatile("s_waitcnt vmcnt(0)" ::: "memory")
#define RESC(a) do { if (__any((a) < 1.f)) { if (hi == 0) al_l[r32] = (a); asm volatile("s_waitcnt lgkmcnt(0)" ::: "memory"); \
    _Pragma("unroll") for (int d = 0; d < 4; ++d) _Pragma("unroll") for (int r = 0; r < 16; ++r) o[d][r] *= al_l[crow(r, hi)]; } } while (0)
#define MASK(P0, P1, j) do { if (CAUSAL) { const int t_ = (j) - (NT - 4); if (t_ >= 0 && 64 * t_ + 63 > 32 * wid) cmask(P0, P1, t_, 32 * wid + r32, hi); } } while (0)
    f32x16 p0, p1; float mn, al; bf16x8 pa0, pa1, pa2, pa3;
    SLOAD(0); SWAIT(); SWRITE(0); __syncthreads();
#define ATT_STEP(j, b) do { \
        if ((j) + 1 < NT) SLOAD(((j) + 1) * KVBLK); ATT_SBAR(); \
        qkt<DK>(p0, p1, K_lds + (b) * SHM_K, qr, r32, hi); MASK(p0, p1, (j)); partialSM(p0, p1, m_reg, mn, al); RESC(al); \
        finishSM(p0, p1, al, l_reg, pa0, pa1, pa2, pa3); ATT_SBAR(); \
        pv_d0(o, vb0 + (b) * SHM_V, pa0, pa1, pa2, pa3); \
        if ((j) + 1 < NT) { SWAIT(); SWRITE((b) ^ 1); } \
        __syncthreads(); } while (0)
    for (int j = 0; j < NT; j += 2) { ATT_STEP(j, 0); ATT_STEP(j + 1, 1); }
#undef ATT_STEP
    if (hi == 0) li_l[r32] = l_reg; asm volatile("s_waitcnt lgkmcnt(0)" ::: "memory");
    float rli[16];
#pragma unroll
    for (int r = 0; r < 16; ++r) rli[r] = __builtin_amdgcn_rcpf(li_l[crow(r, hi)]);
    bf16_t* Ow = O + (size_t)(wid * QBLK) * ldo;
#pragma unroll
    for (int r = 0; r < 16; ++r) { const int orow = crow(r, hi);
#pragma unroll
        for (int d0 = 0; d0 < 4; ++d0) { const unsigned w = cvt_pk_bf16(o[d0][r] * rli[r], 0.f); Ow[(size_t)orow * ldo + d0 * 32 + r32] = (bf16_t)(w & 0xffffu); } }
    __syncthreads();
#undef SLOAD
#undef SWRITE
#undef SWAIT
#undef RESC
#undef MASK
}
}

#define XB_TMO      128
#define XB_XCNT(j)  (256  + 64 * (j))
#define XB_XSUB(j)  (1280 + 64 * (j))
#define XB_XGEN(j)  (2304 + 64 * (j))
#define XB_TOP      3328
#define XB_TOPGEN   3392
#define XCD_BAR_WORDS 3456
#define XB_SPIN_CAP (1u << 18)
__device__ __forceinline__ unsigned xb_ld(unsigned* p)              { return __hip_atomic_load(p, __ATOMIC_RELAXED, __HIP_MEMORY_SCOPE_AGENT); }
__device__ __forceinline__ unsigned xb_add(unsigned* p, unsigned v) { return __hip_atomic_fetch_add(p, v, __ATOMIC_RELAXED, __HIP_MEMORY_SCOPE_AGENT); }
__device__ __forceinline__ unsigned xb_xcc_id() { return (unsigned)__builtin_amdgcn_s_getreg((3 << 11) | 20) & 0xFu; }
#define XB_SPIN(cond, bar) do { unsigned _sp = 0; while (cond) { __builtin_amdgcn_s_sleep(1); \
    if ((++_sp & 255u) == 0u) { if (xb_ld(&(bar)[XB_TMO])) break; if (_sp > XB_SPIN_CAP) { atomicAdd(&(bar)[XB_TMO], 1u); break; } } } } while (0)
struct XcdBarrier { unsigned* bar; unsigned x; volatile LAS unsigned* st; };
__device__ __forceinline__ XcdBarrier xcd_barrier_post(unsigned* bar, volatile LAS unsigned* st) {
    XcdBarrier b; b.bar = bar; b.x = xb_xcc_id(); b.st = st;
    if (threadIdx.x == 0) (void)xb_add(&bar[XB_XCNT(b.x)], 1u);
    return b;
}
__device__ __forceinline__ void xcd_barrier_complete(unsigned* bar, unsigned x, unsigned& nloc, unsigned& nx) {
    const unsigned G = gridDim.x * gridDim.y * gridDim.z;
    unsigned sum, cnt, mine, sp = 0u;
    for (;;) {
        sum = 0u; cnt = 0u; mine = 0u;
#pragma unroll
        for (unsigned j = 0; j < 16; ++j) { const unsigned c = xb_ld(&bar[XB_XCNT(j)]); sum += c; cnt += (c > 0u) ? 1u : 0u; mine = (j == x) ? c : mine; }
        if (sum == G) break;
        __builtin_amdgcn_s_sleep(1);
        if ((++sp & 255u) == 0u) { if (xb_ld(&bar[XB_TMO])) break; if (sp > XB_SPIN_CAP) { atomicAdd(&bar[XB_TMO], 1u); break; } }
    }
    nloc = mine > 0u ? mine : 1u; nx = cnt > 0u ? cnt : 1u;
}
__device__ __forceinline__ void xcd_barrier(const XcdBarrier& b) {
    asm volatile("s_waitcnt vmcnt(0)" ::: "memory");
    __syncthreads();
    if (threadIdx.x == 0) {
        unsigned* bar = b.bar;
        __builtin_amdgcn_s_waitcnt(0);
        unsigned nloc = b.st[0], nx = b.st[1];
        if (nloc == 0u) { xcd_barrier_complete(bar, b.x, nloc, nx); b.st[0] = nloc; b.st[1] = nx; }
        const unsigned old = xb_add(&bar[XB_XSUB(b.x)], 1u);
        const unsigned gen = old / nloc;
        if (old + 1u == (gen + 1u) * nloc) {
            __builtin_amdgcn_fence(__ATOMIC_RELEASE, "agent");
            asm volatile("s_waitcnt vmcnt(0)" ::: "memory");
            const unsigned og = xb_add(&bar[XB_TOP], 1u);
            const unsigned tg = og / nx;
            if (og + 1u == (tg + 1u) * nx) xb_add(&bar[XB_TOPGEN], 1u);
            else XB_SPIN(xb_ld(&bar[XB_TOPGEN]) == tg, bar);
            __builtin_amdgcn_fence(__ATOMIC_ACQUIRE, "agent");
            xb_add(&bar[XB_XGEN(b.x)], 1u);
            asm volatile("s_waitcnt vmcnt(0)" ::: "memory");
        } else {
            XB_SPIN(xb_ld(&bar[XB_XGEN(b.x)]) == gen, bar);
            __builtin_amdgcn_fence(__ATOMIC_ACQUIRE, "agent");
            asm volatile("s_waitcnt vmcnt(0)" ::: "memory");
        }
    }
    __syncthreads();
}

constexpr int NWAVES = 8;
enum { I_X = 0, I_MEM, I_POS, I_F1N, I_F1GU, I_F1DN, I_MIXN, I_WIN, I_WPOOL, I_PSCALE, I_QLN, I_KVLN, I_WUQ, I_WUKV, I_QNN, I_KNN, I_QRN, I_KRN,
       I_WBP, I_WBM, I_WOUT, I_XNORM, I_MEMN, I_WXQ, I_WXKV, I_XQN, I_XKN, I_WXO, I_F2N, I_F2GU, I_F2DN, N_IN };
struct Params { const float* in[N_IN]; float* out; unsigned char* ws; int ph_lo, ph_hi; };
static_assert(sizeof(Params) == (N_IN + 2) * 8 + 8, "Params has no padding");


__constant__ float c_inv_freq[32] = {
    1.000000000e+00f, 7.498942018e-01f, 5.623413324e-01f, 4.216965139e-01f, 3.162277639e-01f, 2.371373922e-01f, 1.778279394e-01f, 1.333521456e-01f,
    1.000000015e-01f, 7.498941571e-02f, 5.623412877e-02f, 4.216964915e-02f, 3.162277862e-02f, 2.371373586e-02f, 1.778279431e-02f, 1.333521493e-02f,
    9.999999776e-03f, 7.498942316e-03f, 5.623413250e-03f, 4.216964822e-03f, 3.162277862e-03f, 2.371373819e-03f, 1.778279431e-03f, 1.333521446e-03f,
    1.000000047e-03f, 7.498941850e-04f, 5.623413017e-04f, 4.216965463e-04f, 3.162277862e-04f, 2.371373848e-04f, 1.778279402e-04f, 1.333521504e-04f};

#define LDS_WAIT() asm volatile("s_waitcnt lgkmcnt(0)" ::: "memory")
__device__ __forceinline__ float wave_sum(float v) {
#pragma unroll
    for (int o = 1; o < 64; o <<= 1) v += __shfl_xor(v, o);
    return v;
}
__device__ __forceinline__ unsigned f2bf(float f) { unsigned u = __builtin_bit_cast(unsigned, f); return (u + 0x7fffu + ((u >> 16) & 1u)) >> 16; }
__device__ __forceinline__ unsigned pk2(float lo, float hi) { return f2bf(lo) | (f2bf(hi) << 16); }

template <int MAP> __device__ __forceinline__ int dst_row_of(int n0) {
    if (MAP == 1) { const int isu = n0 >= FF, j = isu ? n0 - FF : n0; return (j >> 7) * 256 + isu * 128 + (j & 127); }
    if (MAP == 2) { if (n0 < 3584) return n0; if (n0 < 3648) return Z_KR + (n0 - 3584); if (n0 < 7744) return Z_GP + (n0 - 3648); return Z_GM + (n0 - 7744); }
    return n0;
}
template <int MAP> __device__ __forceinline__ void transpose_item(const float* W, int K, int N, bf16_t* WT, LAS float* scr, int item, int lane) {
    const int nblk = N / 64, kb = item / nblk, nb = item % nblk, k0 = 64 * kb, n0 = 64 * nb, d0 = dst_row_of<MAP>(n0);
    const int q = lane >> 4, l15 = lane & 15;
    f32x4 v[16];
#pragma unroll
    for (int i = 0; i < 16; ++i) v[i] = __builtin_nontemporal_load((const f32x4*)(W + (size_t)(k0 + 4 * i + q) * N + n0 + l15 * 4));
#pragma unroll
    for (int i = 0; i < 16; ++i) { LAS float* s = scr + (4 * i + q) * 65 + l15 * 4; s[0] = v[i].x; s[1] = v[i].y; s[2] = v[i].z; s[3] = v[i].w; }
    LDS_WAIT(); asm volatile("" ::: "memory");
    const int c = lane & 7;
#pragma unroll
    for (int j = 0; j < 8; ++j) { const int n = (lane >> 3) + 8 * j; const LAS float* s = scr + (8 * c) * 65 + n;
        u32x4 o; o.x = cvt_pk_bf16(s[0 * 65], s[1 * 65]); o.y = cvt_pk_bf16(s[2 * 65], s[3 * 65]); o.z = cvt_pk_bf16(s[4 * 65], s[5 * 65]); o.w = cvt_pk_bf16(s[6 * 65], s[7 * 65]);
        *(GAS u32x4*)(WT + (size_t)(d0 + n) * K + k0 + 8 * c) = o; }
    LDS_WAIT(); asm volatile("" ::: "memory");
}
__device__ __forceinline__ void rms_row_4096(const float* xrow, const float* gain, bf16_t* orow, int lane) {
    const f32x4* xr = (const f32x4*)xrow + lane * 2; const f32x4* gr = (const f32x4*)gain + lane * 2;
    f32x4 v[16]; float s = 0.f;
#pragma unroll
    for (int j = 0; j < 8; ++j) { v[2 * j] = xr[128 * j]; v[2 * j + 1] = xr[128 * j + 1];
        s += (v[2 * j].x * v[2 * j].x + v[2 * j].y * v[2 * j].y) + (v[2 * j].z * v[2 * j].z + v[2 * j].w * v[2 * j].w);
        s += (v[2 * j + 1].x * v[2 * j + 1].x + v[2 * j + 1].y * v[2 * j + 1].y) + (v[2 * j + 1].z * v[2 * j + 1].z + v[2 * j + 1].w * v[2 * j + 1].w); }
    const float rstd = rsqrtf(wave_sum(s) * (1.f / 4096.f) + EPS);
    u32x4* o16 = (u32x4*)orow + lane;
#pragma unroll
    for (int j = 0; j < 8; ++j) { const f32x4 g0 = gr[128 * j], g1 = gr[128 * j + 1]; const f32x4 a = v[2 * j] * rstd * g0, b = v[2 * j + 1] * rstd * g1;
        u32x4 w; w.x = cvt_pk_bf16(a.x, a.y); w.y = cvt_pk_bf16(a.z, a.w); w.z = cvt_pk_bf16(b.x, b.y); w.w = cvt_pk_bf16(b.z, b.w); o16[64 * j] = w; }
}
__device__ __forceinline__ void unpack8(const u32x4 v, float (&f)[8]) { f[0] = bf_lo(v.x); f[1] = bf_hi(v.x); f[2] = bf_lo(v.y); f[3] = bf_hi(v.y); f[4] = bf_lo(v.z); f[5] = bf_hi(v.z); f[6] = bf_lo(v.w); f[7] = bf_hi(v.w); }
__device__ __forceinline__ u32x4 pack8(const float (&f)[8]) { u32x4 w; w.x = cvt_pk_bf16(f[0], f[1]); w.y = cvt_pk_bf16(f[2], f[3]); w.z = cvt_pk_bf16(f[4], f[5]); w.w = cvt_pk_bf16(f[6], f[7]); return w; }

#ifndef RP_B
#define RP_B 1
#endif
#ifndef RP_C
#define RP_C 1
#endif
constexpr int N_PHASES = 16;

__global__ void __launch_bounds__(NWAVES * 64, 2) mk_fwd(Params P) {
    extern __shared__ __attribute__((aligned(16))) unsigned char lds_raw[];
#define LDSP ((LAS unsigned char*)lds_raw)
#define WSB (P.ws)
    unsigned* ctl = (unsigned*)(WSB + WS_CTL);
    for (int u = threadIdx.x; u < (LDS_BYTES - LDSCTL_OFF) / 4; u += NWAVES * 64) ((LAS unsigned*)(LDSP + LDSCTL_OFF))[u] = 0u;
    __syncthreads();
#if MK_ONE_LAUNCH
    (void)xcd_barrier_post(ctl + CW_BAR, (volatile LAS unsigned*)(LDSP + MISC_OFF) + 8);
#define GRID_BAR() do { XcdBarrier b_; b_.bar = (unsigned*)(WSB + WS_CTL) + CW_BAR; b_.x = xb_xcc_id(); b_.st = (volatile LAS unsigned*)((LAS unsigned char*)lds_raw + MISC_OFF) + 8; xcd_barrier(b_); } while (0)
    constexpr int lo = 0, hi = N_PHASES;
#else
#define GRID_BAR() do { } while (0)
    const int lo = P.ph_lo, hi = P.ph_hi;
#endif
#ifndef MK_PHASES
#define MK_PHASES 0xffff
#endif
#define IN(k) ((((MK_PHASES) >> (k)) & 1) && lo <= (k) && (k) < hi)
#define SEAM(k) do { if (IN(k) && IN((k) + 1)) GRID_BAR(); } while (0)
#define PHASE_IDS() int tid_ = threadIdx.x; asm volatile("" : "+v"(tid_)); const int lane = tid_ & 63, wave_ = __builtin_amdgcn_readfirstlane(tid_ >> 6); \
    const int G_ = gridDim.x, vcu_ = (G_ % 8 == 0) ? ((int)blockIdx.x % 8) * (G_ / 8) + (int)blockIdx.x / 8 : (int)blockIdx.x, gw = vcu_ * NWAVES + wave_, NGW = G_ * NWAVES; (void)gw; (void)NGW; (void)lane; (void)vcu_; (void)wave_

#define WGU ((bf16_t*)(WSB + WS_WGU))
#define WDN ((bf16_t*)(WSB + WS_WDN))
#define WIN ((bf16_t*)(WSB + WS_WIN))
#define WPOOL ((bf16_t*)(WSB + WS_WPOOL))
#define WUQ ((bf16_t*)(WSB + WS_WUQ))
#define WUKV ((bf16_t*)(WSB + WS_WUKV))
#define WBP ((bf16_t*)(WSB + WS_WBP))
#define WBM ((bf16_t*)(WSB + WS_WBM))
#define WOUT ((bf16_t*)(WSB + WS_WOUT))
#define WXQ ((bf16_t*)(WSB + WS_WXQ))
#define WXKV ((bf16_t*)(WSB + WS_WXKV))
#define WXO ((bf16_t*)(WSB + WS_WXO))
#define XN ((bf16_t*)(WSB + WS_XN))
#define MN ((bf16_t*)(WSB + WS_MN))
#define XKV ((float*)(WSB + WS_XKV))
#define XKB ((bf16_t*)(WSB + WS_XKB))
#define XVB ((bf16_t*)(WSB + WS_XVB))
#define HID ((bf16_t*)(WSB + WS_HID))
#define Z ((bf16_t*)(WSB + WS_Z))
#define CQ ((bf16_t*)(WSB + WS_CQ))
#define CKV ((bf16_t*)(WSB + WS_CKV))
#define KR ((bf16_t*)(WSB + WS_KR))
#define PM ((bf16_t*)(WSB + WS_PM))
#define QB ((bf16_t*)(WSB + WS_Q))
#define KVB ((bf16_t*)(WSB + WS_KV))
#define AO ((bf16_t*)(WSB + WS_AO))
#define BO ((bf16_t*)(WSB + WS_BO))
#define MG XN
#define XQP ((float*)(WSB + WS_XQP))
#define XO ((bf16_t*)(WSB + WS_XO))
#define UQ ((bf16_t*)(WSB + WS_UQ))
#define SS0 ((float*)(WSB + WS_SS))
#define SS1 ((float*)(WSB + WS_SS) + M)
#define SS2 ((float*)(WSB + WS_SS) + 2 * M)
#define OUT (P.out)

#define TRANSPOSE_JOB(MAP, SRC, KK, NN, DST) { const int nit = ((KK) / 64) * ((NN) / 64); if (r < nit) { transpose_item<MAP>((SRC), (KK), (NN), (DST), scr, r, lane); continue; } r -= nit; }

#if RP_C > 1
    for (int rep_ = 0; rep_ < RP_C; ++rep_) { if (rep_) GRID_BAR();
#endif
    if (IN(0)) {
        PHASE_IDS();
        LAS float* scr = (LAS float*)(LDSP + wave_ * 16896);
        constexpr int TOT = (D / 64) * (2 * FF / 64) + (FF / 64) * (D / 64) + (D / 64) * (11840 / 64) + (2048 / 64) * (512 / 64) + (1024 / 64) * (3072 / 64) + (512 / 64) * (4096 / 64)
                          + 2 * (2048 / 64) * (4096 / 64) + (4096 / 64) * (4096 / 64) + (4096 / 64) * (512 / 64) + (4096 / 64) * (1024 / 64) + (512 / 64) * (4096 / 64);
        for (int it = gw; it < TOT; it += NGW) {
            int r = it;
            TRANSPOSE_JOB(1, P.in[I_F1GU], D, 2 * FF, WGU)
            TRANSPOSE_JOB(0, P.in[I_F1DN], FF, D, WDN)
            TRANSPOSE_JOB(2, P.in[I_WIN], D, 11840, WIN)
            TRANSPOSE_JOB(0, P.in[I_WPOOL], 2048, 512, WPOOL)
            TRANSPOSE_JOB(0, P.in[I_WUQ], 1024, 3072, WUQ)
            TRANSPOSE_JOB(0, P.in[I_WUKV], 512, 4096, WUKV)
            TRANSPOSE_JOB(0, P.in[I_WBP], 2048, 4096, WBP)
            TRANSPOSE_JOB(0, P.in[I_WBM], 2048, 4096, WBM)
            TRANSPOSE_JOB(0, P.in[I_WOUT], 4096, 4096, WOUT)
            TRANSPOSE_JOB(0, P.in[I_WXQ], 4096, 512, WXQ)
            TRANSPOSE_JOB(0, P.in[I_WXKV], 4096, 1024, WXKV)
            TRANSPOSE_JOB(0, P.in[I_WXO], 512, 4096, WXO)
        }
        { u32x4* zp = (u32x4*)(WIN + (size_t)11840 * D); const int n16 = 192 * D * 2 / 16; for (int i = gw * 64 + lane; i < n16; i += NGW * 64) zp[i] = (u32x4){0u, 0u, 0u, 0u}; }
        for (int m = gw; m < M; m += NGW) rms_row_4096(P.in[I_X] + (size_t)m * D, P.in[I_F1N], XN + (size_t)m * D, lane);
        for (int m = gw; m < MMEM; m += NGW) rms_row_4096(P.in[I_MEM] + (size_t)m * D, P.in[I_MEMN], MN + (size_t)m * D, lane);
    }
#if RP_C > 1
    }
#endif
    SEAM(0);
    if (IN(1)) {
        pg8::Gemm g = pg8::mk_gemm(XN, WGU, D, D, D); pg8::StaticOrder S; S.init(M / 256, FF / 128, (int)gridDim.x, (int)blockIdx.x);
        pg8::EpiSwiGLU E{HID, FF, nullptr};
        pg8::gemm_phase(LDSP, g, S, E);
    }
    SEAM(1);
    if (IN(2)) {
        pg8::Gemm g = pg8::mk_gemm(HID, WDN, FF, FF, FF); pg8::StaticOrder S; S.init(M / 256, D / 256, (int)gridDim.x, (int)blockIdx.x);
        pg8::EpiRes<true> E{P.in[I_X], OUT, D, 0.5f, XN, P.in[I_MIXN], SS0};
        pg8::gemm_phase(LDSP, g, S, E);
    }
    SEAM(2);
    if (IN(3)) {
        { pg8::Gemm g = pg8::mk_gemm(XN, WIN, D, D, D); pg8::StaticOrder S; S.init(M / 256, ZW / 256, (int)gridDim.x, (int)blockIdx.x);
          pg8::EpiBf16S E{Z, ZW, nullptr, SS0};
          pg8::gemm_phase(LDSP, g, S, E); }
        { pg8::Gemm g = pg8::mk_gemm(MN, WXKV, D, D, D); pg8::StaticOrder S; S.init(MMEM / 256, 1024 / 256, (int)gridDim.x, (int)((blockIdx.x + 64u) % (unsigned)(int)gridDim.x));
          pg8::EpiF32Split E{XKV, 1024, 0x7fffffff, 30, 0, nullptr};
          pg8::gemm_phase(LDSP, g, S, E); }
    }
    SEAM(3);
    if (IN(4)) {
        PHASE_IDS();
        const float* gq = P.in[I_QLN]; const float* gkv = P.in[I_KVLN]; const float* gkr = P.in[I_KRN]; const int* pos = (const int*)P.in[I_POS];
        for (int m = gw; m < M; m += NGW) {
            const bf16_t* zr = Z + (size_t)m * ZW;
            {
                float a[8], b[8]; unpack8(*(const u32x4*)(zr + Z_ZQ + lane * 8), a); unpack8(*(const u32x4*)(zr + Z_ZQ + 512 + lane * 8), b);
                float s = 0.f;
#pragma unroll
                for (int e = 0; e < 8; ++e) s += a[e] * a[e] + b[e] * b[e];
                const float rstd = rsqrtf(wave_sum(s) * (1.f / 1024.f) + EPS);
#pragma unroll
                for (int e = 0; e < 8; ++e) { a[e] *= rstd * gq[lane * 8 + e]; b[e] *= rstd * gq[512 + lane * 8 + e]; }
                *(u32x4*)(CQ + (size_t)m * 1024 + lane * 8) = pack8(a); *(u32x4*)(CQ + (size_t)m * 1024 + 512 + lane * 8) = pack8(b); }
            {
                float a[8]; unpack8(*(const u32x4*)(zr + Z_ZKV + lane * 8), a);
                float s = 0.f;
#pragma unroll
                for (int e = 0; e < 8; ++e) s += a[e] * a[e];
                const float rstd = rsqrtf(wave_sum(s) * (1.f / 512.f) + EPS);
#pragma unroll
                for (int e = 0; e < 8; ++e) a[e] *= rstd * gkv[lane * 8 + e];
                *(u32x4*)(CKV + (size_t)m * 512 + lane * 8) = pack8(a); }
            {
                const float x = bf_lo((unsigned)zr[Z_KR + lane]);
                const float rstd = rsqrtf(wave_sum(x * x) * (1.f / 64.f) + EPS);
                const float y = x * rstd * gkr[lane], yp = __shfl_xor(y, 32);
                const float ang = (float)pos[m] * c_inv_freq[lane & 31], cs = cosf(ang), sn = sinf(ang);
                const float o = (lane < 32) ? (y * cs - yp * sn) : (y * cs + yp * sn);
                KR[(size_t)m * 64 + lane] = (bf16_t)f2bf(o); }
            {
                const int t = m & (SEQ - 1);
#pragma unroll
                for (int g = 0; g < 4; ++g) { const int w = 2 << g; float acc[8], own[8];
                    unpack8(*(const u32x4*)(zr + Z_ZP + g * 512 + lane * 8), own);
#pragma unroll
                    for (int e = 0; e < 8; ++e) acc[e] = own[e];
                    const int nb = t < (w - 1) ? t : (w - 1);
                    for (int j = 1; j <= nb; ++j) { float v[8]; unpack8(*(const u32x4*)(zr - (size_t)j * ZW + Z_ZP + g * 512 + lane * 8), v);
#pragma unroll
                        for (int e = 0; e < 8; ++e) acc[e] += v[e]; }
                    const float inv = 1.0f / (float)(nb + 1);
#pragma unroll
                    for (int e = 0; e < 8; ++e) acc[e] = acc[e] * inv - own[e];
                    *(u32x4*)(PM + (size_t)m * 2048 + g * 512 + lane * 8) = pack8(acc); } }
        }
        {
            const float* gxk = P.in[I_XKN];
            for (int m = gw; m < MMEM; m += NGW) {
                const float* kr = XKV + (size_t)m * 1024 + lane * 8; const float* vr = kr + 512;
                const f32x4 k0 = *(const f32x4*)kr, k1 = *(const f32x4*)(kr + 4), v0 = *(const f32x4*)vr, v1 = *(const f32x4*)(vr + 4);
                float s = (k0.x * k0.x + k0.y * k0.y) + (k0.z * k0.z + k0.w * k0.w) + (k1.x * k1.x + k1.y * k1.y) + (k1.z * k1.z + k1.w * k1.w);
                s += __shfl_xor(s, 1); s += __shfl_xor(s, 2); s += __shfl_xor(s, 4); s += __shfl_xor(s, 8);
                const float rstd = rsqrtf(s * (1.f / 128.f) + EPS); const int c = (lane & 15) * 8;
                float a[8] = {k0.x * rstd * gxk[c], k0.y * rstd * gxk[c + 1], k0.z * rstd * gxk[c + 2], k0.w * rstd * gxk[c + 3], k1.x * rstd * gxk[c + 4], k1.y * rstd * gxk[c + 5], k1.z * rstd * gxk[c + 6], k1.w * rstd * gxk[c + 7]};
                float bb[8] = {v0.x, v0.y, v0.z, v0.w, v1.x, v1.y, v1.z, v1.w};
                *(u32x4*)(XKB + (size_t)m * 512 + lane * 8) = pack8(a); *(u32x4*)(XVB + (size_t)m * 512 + lane * 8) = pack8(bb);
            } }
        {
            LAS float* scr = (LAS float*)(LDSP + wave_ * 16896);
            constexpr int TOT = (D / 64) * (2 * FF / 64) + (FF / 64) * (D / 64);
            for (int it = gw; it < TOT; it += NGW) {
                int r = it;
                TRANSPOSE_JOB(1, P.in[I_F2GU], D, 2 * FF, WGU)
                TRANSPOSE_JOB(0, P.in[I_F2DN], FF, D, WDN)
            } }
    }
    SEAM(4);
    if (IN(5)) {
        { pg8::Gemm g = pg8::mk_gemm(CQ, WUQ, 1024, 1024, 1024); pg8::StaticOrder S; S.init(M / 256, QW / 256, (int)gridDim.x, (int)blockIdx.x);
          pg8::EpiBf16S E{QB, QW, nullptr, nullptr}; pg8::gemm_phase(LDSP, g, S, E); }
        { pg8::Gemm g = pg8::mk_gemm(CKV, WUKV, 512, 512, 512); pg8::StaticOrder S; S.init(M / 256, KVW / 256, (int)gridDim.x, (int)blockIdx.x);
          pg8::EpiBf16S E{KVB, KVW, nullptr, nullptr}; pg8::gemm_phase(LDSP, g, S, E); }
        { pg8::Gemm g = pg8::mk_gemm(PM, WPOOL, 2048, 2048, 512); g.ashift = 1; g.astride = 512; g.bmask = 1; g.bstride = 512;
          pg8::StaticOrder S; S.init(M / 256, AW / 256, (int)gridDim.x, (int)blockIdx.x);
          pg8::EpiBf16S E{AO, AW, P.in[I_PSCALE], nullptr}; pg8::gemm_phase(LDSP, g, S, E); }
    }
    SEAM(5);
    if (IN(6)) {
        PHASE_IDS();
        const float* gqn = P.in[I_QNN]; const float* gkn = P.in[I_KNN]; const float* gqr = P.in[I_QRN]; const int* pos = (const int*)P.in[I_POS];
        for (int m = gw; m < M; m += NGW) {
            const float ang = (float)pos[m] * c_inv_freq[lane & 31], cs = cosf(ang), sn = sinf(ang);
            const int sub = lane & 15;
#pragma unroll
            for (int it = 0; it < 4; ++it) { const int head = 4 * it + (lane >> 4);
                { bf16_t* p = QB + (size_t)m * QW + head * 192 + sub * 8; float a[8]; unpack8(*(const u32x4*)p, a); float s = 0.f;
#pragma unroll
                  for (int e = 0; e < 8; ++e) s += a[e] * a[e];
                  s += __shfl_xor(s, 1); s += __shfl_xor(s, 2); s += __shfl_xor(s, 4); s += __shfl_xor(s, 8);
                  const float rstd = rsqrtf(s * (1.f / 128.f) + EPS) * QSCALE;
#pragma unroll
                  for (int e = 0; e < 8; ++e) a[e] *= rstd * gqn[sub * 8 + e];
                  *(u32x4*)p = pack8(a); }
                { bf16_t* p = KVB + (size_t)m * KVW + head * 256 + sub * 8; float a[8]; unpack8(*(const u32x4*)p, a); float s = 0.f;
#pragma unroll
                  for (int e = 0; e < 8; ++e) s += a[e] * a[e];
                  s += __shfl_xor(s, 1); s += __shfl_xor(s, 2); s += __shfl_xor(s, 4); s += __shfl_xor(s, 8);
                  const float rstd = rsqrtf(s * (1.f / 128.f) + EPS);
#pragma unroll
                  for (int e = 0; e < 8; ++e) a[e] *= rstd * gkn[sub * 8 + e];
                  *(u32x4*)p = pack8(a); } }
            const int j8 = lane & 7;
#pragma unroll
            for (int it = 0; it < 2; ++it) { const int head = 8 * it + (lane >> 3);
                bf16_t* p = QB + (size_t)m * QW + head * 192 + 128 + j8 * 8; float a[8]; unpack8(*(const u32x4*)p, a); float s = 0.f;
#pragma unroll
                for (int e = 0; e < 8; ++e) s += a[e] * a[e];
                s += __shfl_xor(s, 1); s += __shfl_xor(s, 2); s += __shfl_xor(s, 4);
                const float rstd = rsqrtf(s * (1.f / 64.f) + EPS);
                float o[8];
#pragma unroll
                for (int e = 0; e < 8; ++e) { const float y = a[e] * rstd * gqr[j8 * 8 + e], yp = __shfl_xor(y, 4); const int i = 8 * (j8 & 3) + e;
                    const float c = __shfl(cs, i), sv = __shfl(sn, i); o[e] = ((j8 < 4) ? (y * c - yp * sv) : (y * c + yp * sv)) * QSCALE; }
                *(u32x4*)p = pack8(o); }
        }
    }
    SEAM(6);
#if RP_B > 1
    for (int rep_ = 0; rep_ < RP_B; ++rep_) { if (rep_) GRID_BAR();
#endif
    if (IN(7)) {
        PHASE_IDS();
        const int r32 = lane & 31, hi5 = lane >> 5;
        for (int item = vcu_; item < 512; item += (int)gridDim.x) {
            const int bh = item >> 4, x = item & 15, b = bh >> 4, h = bh & 15;
#pragma unroll 1
            for (int half = 0; half < 2; ++half) {
                const int qb = half ? 31 - x : x;
                const size_t row0 = (size_t)b * SEQ + (size_t)qb * 256;
                bf16x8 qr[12];
                const bf16_t* Qw = QB + (row0 + wave_ * 32 + r32) * QW + h * 192 + hi5 * 8;
#pragma unroll
                for (int d0 = 0; d0 < 12; ++d0) qr[d0] = *(const bf16x8*)(Qw + d0 * 16);
                att::attn_unit<192, true>(qr, KVB + (size_t)b * SEQ * KVW + h * 256, KVW, KR + (size_t)b * SEQ * 64, 64, KVB + (size_t)b * SEQ * KVW + h * 256 + 128, KVW,
                                          BO + row0 * AW + h * 128, AW, 4 * (qb + 1), (char*)lds_raw);
            }
        }
    }
#if RP_B > 1
    }
#endif
    SEAM(7);
    if (IN(8)) {
        pg8::Gemm g = pg8::mk_gemm(AO, WBP, AW, AW, AW); pg8::StaticOrder S; S.init(M / 256, D / 256, (int)gridDim.x, (int)blockIdx.x);
        pg8::EpiMerge<false> E{MG, D, Z + Z_GP, ZW}; pg8::gemm_phase(LDSP, g, S, E);
    }
    SEAM(8);
    if (IN(9)) {
        pg8::Gemm g = pg8::mk_gemm(BO, WBM, AW, AW, AW); pg8::StaticOrder S; S.init(M / 256, D / 256, (int)gridDim.x, (int)blockIdx.x);
        pg8::EpiMerge<true> E{MG, D, Z + Z_GM, ZW}; pg8::gemm_phase(LDSP, g, S, E);
    }
    SEAM(9);
    if (IN(10)) {
        pg8::Gemm g = pg8::mk_gemm(MG, WOUT, D, D, D); pg8::StaticOrder S; S.init(M / 256, D / 256, (int)gridDim.x, (int)blockIdx.x);
        pg8::EpiRes<true> E{OUT, OUT, D, 1.0f, UQ, P.in[I_XNORM], SS1}; pg8::gemm_phase(LDSP, g, S, E);
    }
    SEAM(10);
    if (IN(11)) {
        pg8::Gemm g = pg8::mk_gemm(UQ, WXQ, D, D, 2048); g.ashift = 1; g.astride = 2048; g.bmask = 1; g.bstride = 2048;
        pg8::StaticOrder S; S.init(M / 256, 4, (int)gridDim.x, (int)blockIdx.x);
        pg8::EpiF32Split E{XQP, 512, 1, 1, (size_t)M * 512, SS1}; pg8::gemm_phase(LDSP, g, S, E);
    }
    SEAM(11);
    if (IN(12)) {
        PHASE_IDS();
        const int r32 = lane & 31, hi5 = lane >> 5; const float* gxq = P.in[I_XQN];
        for (int item = vcu_; item < 256; item += (int)gridDim.x) {
            const int bh = item >> 5, qb = item & 31, b = bh >> 2, h = bh & 3;
            const size_t row0 = (size_t)b * SEQ + (size_t)qb * 256;
            bf16x8 qr[8];
            { const float* q0 = XQP + (row0 + wave_ * 32 + r32) * 512 + h * 128 + hi5 * 8; const float* q1 = q0 + (size_t)M * 512;
              f32x4 qa[8], qbv[8]; float s = 0.f;
#pragma unroll
              for (int d0 = 0; d0 < 8; ++d0) { qa[d0] = *(const f32x4*)(q0 + d0 * 16) + *(const f32x4*)(q1 + d0 * 16); qbv[d0] = *(const f32x4*)(q0 + d0 * 16 + 4) + *(const f32x4*)(q1 + d0 * 16 + 4);
                  s += (qa[d0].x * qa[d0].x + qa[d0].y * qa[d0].y) + (qa[d0].z * qa[d0].z + qa[d0].w * qa[d0].w) + (qbv[d0].x * qbv[d0].x + qbv[d0].y * qbv[d0].y) + (qbv[d0].z * qbv[d0].z + qbv[d0].w * qbv[d0].w); }
              s += __shfl_xor(s, 32);
              const float rstd = rsqrtf(s * (1.f / 128.f) + EPS) * XSCALE;
#pragma unroll
              for (int d0 = 0; d0 < 8; ++d0) { const float* gp = gxq + d0 * 16 + hi5 * 8; const f32x4 g0 = *(const f32x4*)gp, g1 = *(const f32x4*)(gp + 4);
                  const f32x4 a = qa[d0] * rstd * g0, c = qbv[d0] * rstd * g1; u32x4 w; w.x = cvt_pk_bf16(a.x, a.y); w.y = cvt_pk_bf16(a.z, a.w); w.z = cvt_pk_bf16(c.x, c.y); w.w = cvt_pk_bf16(c.z, c.w);
                  qr[d0] = __builtin_bit_cast(bf16x8, w); } }
            att::attn_unit<128, false>(qr, XKB + (size_t)b * 256 * 512 + h * 128, 512, nullptr, 0, XVB + (size_t)b * 256 * 512 + h * 128, 512,
                                       XO + row0 * 512 + h * 128, 512, 4, (char*)lds_raw);
        }
    }
    SEAM(12);
    if (IN(13)) {
        pg8::Gemm g = pg8::mk_gemm(XO, WXO, 512, 512, 512); pg8::StaticOrder S; S.init(M / 256, D / 256, (int)gridDim.x, (int)blockIdx.x);
        pg8::EpiRes<true> E{OUT, OUT, D, 1.0f, XN, P.in[I_F2N], SS2}; pg8::gemm_phase(LDSP, g, S, E);
    }
    SEAM(13);
    if (IN(14)) {
        pg8::Gemm g = pg8::mk_gemm(XN, WGU, D, D, D); pg8::StaticOrder S; S.init(M / 256, FF / 128, (int)gridDim.x, (int)blockIdx.x);
        pg8::EpiSwiGLU E{HID, FF, SS2}; pg8::gemm_phase(LDSP, g, S, E);
    }
    SEAM(14);
    if (IN(15)) {
        pg8::Gemm g = pg8::mk_gemm(HID, WDN, FF, FF, FF); pg8::StaticOrder S; S.init(M / 256, D / 256, (int)gridDim.x, (int)blockIdx.x);
        pg8::EpiRes<false> E{OUT, OUT, D, 0.5f, nullptr, nullptr, nullptr}; pg8::gemm_phase(LDSP, g, S, E);
    }
#undef IN
#undef SEAM
#undef TRANSPOSE_JOB
}

extern "C" void kernel_launch(void* const* d_in, const int* in_sizes, int n_in, void* d_out, int out_size, void* d_ws, size_t ws_size, hipStream_t stream) {
    static int grid = 0;
    if (grid == 0) {
        if (n_in != N_IN || in_sizes[0] != M * D || out_size != M * D || ws_size < WS_END) {
            fprintf(stderr, "kernel_launch: unexpected shapes: n_in %d in0 %d out %d ws %zu (need %zu)\n", n_in, n_in > 0 ? in_sizes[0] : -1, out_size, ws_size, (size_t)WS_END); grid = -1; return; }
        int dev = 0, cus = 0;
        if (hipGetDevice(&dev) != hipSuccess || hipDeviceGetAttribute(&cus, hipDeviceAttributeMultiprocessorCount, dev) != hipSuccess) { grid = -1; return; }
        if (hipFuncSetAttribute((const void*)mk_fwd, hipFuncAttributeMaxDynamicSharedMemorySize, LDS_BYTES) != hipSuccess) { fprintf(stderr, "kernel_launch: hipFuncSetAttribute failed\n"); grid = -1; return; }
        int per_cu = 0;
        if (hipOccupancyMaxActiveBlocksPerMultiprocessor(&per_cu, (const void*)mk_fwd, NWAVES * 64, LDS_BYTES) != hipSuccess || per_cu < 1) { fprintf(stderr, "kernel_launch: occupancy query says %d\n", per_cu); }
        (void)hipGetLastError();
        grid = cus;
    }
    if (grid < 0) return;
    (void)hipMemsetAsync((char*)d_ws + WS_CTL, 0, CTL_ZERO_BYTES, stream);
    Params p{};
    for (int i = 0; i < N_IN; ++i) p.in[i] = (const float*)d_in[i];
    p.out = (float*)d_out; p.ws = (unsigned char*)d_ws;
#if MK_ONE_LAUNCH
    p.ph_lo = 0; p.ph_hi = N_PHASES;
    hipLaunchKernelGGL(mk_fwd, dim3(grid), dim3(NWAVES * 64), LDS_BYTES, stream, p);
#else
    for (int k = 0; k < N_PHASES; ++k) { p.ph_lo = k; p.ph_hi = k + 1; hipLaunchKernelGGL(mk_fwd, dim3(grid), dim3(NWAVES * 64), LDS_BYTES, stream, p); }
#endif
    const hipError_t le = hipPeekAtLastError();
    if (le != hipSuccess) fprintf(stderr, "kernel_launch: launch failed: %s\n", hipGetErrorName(le));
}
```

```cpp
#include <hip/hip_runtime.h>
#include <cstdio>
#include <cstdint>

#ifndef MK_ONE_LAUNCH
#define MK_ONE_LAUNCH 1
#endif
#ifndef PROBE_MODE
#define PROBE_MODE 0
#endif

#define LAS __attribute__((address_space(3)))
#define GAS __attribute__((address_space(1)))
typedef unsigned short bf16_t;
typedef short bf16x8 __attribute__((ext_vector_type(8)));
typedef short s16x4 __attribute__((ext_vector_type(4)));
typedef float f32x2 __attribute__((ext_vector_type(2)));
typedef float f32x4 __attribute__((ext_vector_type(4)));
typedef float f32x16 __attribute__((ext_vector_type(16)));
typedef unsigned u32x2 __attribute__((ext_vector_type(2)));
typedef unsigned u32x4 __attribute__((ext_vector_type(4)));

constexpr int D = 4096, SEQ = 8192, M = 16384, MMEM = 512, FF = 11008;
constexpr int ZW = 12032;
constexpr int Z_ZP = 0, Z_ZQ = 2048, Z_ZKV = 3072, Z_GP = 3584, Z_GM = 7680, Z_KR = 11776;
constexpr int NH = 16, QW = 3072, KVW = 4096, AW = 2048;
constexpr float EPS = 1e-6f;
constexpr float LOG2E = 1.4426950408889634f;
constexpr float QSCALE = 0.07216878364870323f * LOG2E;
constexpr float XSCALE = 0.08838834764831845f * LOG2E;

constexpr size_t MiB = 1u << 20;
constexpr size_t WS_CTL = 0, CTL_ZERO_BYTES = 1 * MiB;
constexpr size_t WS_WGU = 1 * MiB, WS_WDN = 173 * MiB, WS_WIN = 259 * MiB, WS_WPOOL = 353 * MiB, WS_WUQ = 355 * MiB, WS_WUKV = 361 * MiB,
                 WS_WBP = 365 * MiB, WS_WBM = 381 * MiB, WS_WOUT = 397 * MiB, WS_WXQ = 429 * MiB, WS_WXKV = 433 * MiB, WS_WXO = 441 * MiB;
constexpr size_t WS_XN = 445 * MiB, WS_MN = 573 * MiB, WS_XKV = 577 * MiB, WS_XKB = 579 * MiB, WS_XVB = 579 * MiB + 512 * 1024;
constexpr size_t WS_R = 580 * MiB;
constexpr size_t WS_HID = WS_R, WS_Z = WS_R, WS_CQ = WS_R + 376 * MiB, WS_CKV = WS_R + 408 * MiB, WS_KR = WS_R + 424 * MiB, WS_PM = WS_R + 426 * MiB,
                 WS_Q = WS_R + 490 * MiB, WS_KV = WS_R + 586 * MiB, WS_AO = WS_R + 714 * MiB, WS_BO = WS_R + 778 * MiB, WS_CS = WS_R + 842 * MiB, WS_GQ = WS_R + 846 * MiB, WS_END = WS_R + 974 * MiB;
constexpr size_t WS_XQP = WS_R, WS_XO = WS_R + 64 * MiB, WS_UQ = WS_R + 80 * MiB;
constexpr size_t WS_SS = 64 * 1024;
constexpr int CW_BAR = 4096;

constexpr int RING_BYTES = 131072, LDSCTL_OFF = 135168, MISC_OFF = LDSCTL_OFF + 320, LDS_BYTES = 147456;

__device__ __forceinline__ unsigned cvt_pk_bf16(float lo, float hi) { unsigned r; asm volatile("v_cvt_pk_bf16_f32 %0, %1, %2" : "=v"(r) : "v"(lo), "v"(hi)); return r; }
__device__ __forceinline__ float bf_lo(unsigned u) { return __builtin_bit_cast(float, u << 16); }
__device__ __forceinline__ float bf_hi(unsigned u) { return __builtin_bit_cast(float, u & 0xffff0000u); }
__device__ __forceinline__ void unpack8(const u32x4 v, float (&f)[8]) { f[0] = bf_lo(v.x); f[1] = bf_hi(v.x); f[2] = bf_lo(v.y); f[3] = bf_hi(v.y); f[4] = bf_lo(v.z); f[5] = bf_hi(v.z); f[6] = bf_lo(v.w); f[7] = bf_hi(v.w); }
__device__ __forceinline__ u32x4 pack8(const float (&f)[8]) { u32x4 w; w.x = cvt_pk_bf16(f[0], f[1]); w.y = cvt_pk_bf16(f[2], f[3]); w.z = cvt_pk_bf16(f[4], f[5]); w.w = cvt_pk_bf16(f[6], f[7]); return w; }
__device__ __forceinline__ float xsum16(float s) { auto r = __builtin_amdgcn_permlane16_swap(__float_as_uint(s), __float_as_uint(s), false, false); return __uint_as_float(r[0]) + __uint_as_float(r[1]); }
__device__ __forceinline__ float xsum32(float s) { auto r = __builtin_amdgcn_permlane32_swap(__float_as_uint(s), __float_as_uint(s), false, false); return __uint_as_float(r[0]) + __uint_as_float(r[1]); }
typedef short s16x2_t __attribute__((ext_vector_type(2)));
__device__ __forceinline__ float sq2bf(unsigned w, float c) { const s16x2_t a = __builtin_bit_cast(s16x2_t, w); return __builtin_amdgcn_fdot2_f32_bf16(a, a, c, false); }
__device__ __forceinline__ float sigmoidf_(float x) { return __builtin_amdgcn_rcpf(1.0f + __builtin_amdgcn_exp2f(-x * LOG2E)); }

namespace pg8 {
constexpr int BM = 256, BK = 64, HALF = 128, HTB = HALF * BK * 2, STAGE_BYTES = 8 * HTB, NXCD = 8, WGM = 8;
__host__ __device__ __forceinline__ int lds_byte(int r, int c) { const int st = (r >> 4) * 2 + (c >> 5), rr = r & 15, cc = c & 31, ob = rr * 64 + cc * 2; return st * 1024 + (ob ^ (((ob >> 9) & 1) << 5)); }
__host__ __device__ __forceinline__ void stage_rc(int b, int& R, int& C) { const int st = b / 1024, sb = b % 1024, swz = sb ^ (((sb >> 9) & 1) << 5); R = (st >> 1) * 16 + swz / 64; C = (st & 1) * 32 + (swz % 64) / 2; }
__host__ __device__ __forceinline__ int perm32(int rho) { const int n = rho >> 4, i = rho & 15; return 8 * (i >> 2) + 4 * n + (i & 3); }

struct Unit { int pm, pn, seg; };
struct Gemm { const bf16_t* A; const bf16_t* Bt; int lda, ldb, K; int ashift, astride, bmask, bstride; const bf16_t* A2; const bf16_t* Bt2; };
__device__ __forceinline__ Gemm mk_gemm(const bf16_t* A, const bf16_t* Bt, int lda, int ldb, int K) { Gemm g; g.A = A; g.Bt = Bt; g.lda = lda; g.ldb = ldb; g.K = K; g.ashift = 30; g.astride = 0; g.bmask = 0x7fffffff; g.bstride = 0; g.A2 = A; g.Bt2 = Bt; return g; }

struct StaticOrder {
    int nM, nN, nwg, G, c, wgm;
    __host__ __device__ void init(int nM_, int nN_, int G_, int c_, int wgm_ = WGM) { nM = nM_; nN = nN_; nwg = nM * nN; G = G_; c = c_; wgm = wgm_; }
    __host__ __device__ bool next(int i, Unit& u) const {
        const long L = (long)i * G + c; if (L >= nwg) return false;
        int wgid = (int)L; { const int q = nwg / NXCD, r = nwg % NXCD, xcd = wgid % NXCD, off = wgid / NXCD; wgid = (xcd < r ? xcd * (q + 1) : r * (q + 1) + (xcd - r) * q) + off; }
        const int nig = wgm * nN, gid = wgid / nig, fm = gid * wgm, gsz = (nM - fm) < wgm ? (nM - fm) : wgm;
        u.pm = fm + ((wgid % nig) % gsz); u.pn = (wgid % nig) / gsz; u.seg = 0; return true;
    }
};
struct TwoSegOrder : StaticOrder {
    __host__ __device__ bool next(int i, Unit& u) const { if (!StaticOrder::next(i >> 1, u)) return false; u.seg = i & 1; return true; }
};

__device__ __forceinline__ float row_rstd(const float* rowss, int row) { return rowss ? rsqrtf(rowss[row] * (1.f / 4096.f) + 1e-6f) : 1.f; }
template <bool ROWSCALE> struct EpiSwiGLU {
    static constexpr bool TWOSEG = false; static constexpr bool PERM = true;
    bf16_t* H; int ldh; const float* rowss;
    __device__ __forceinline__ void operator()(const f32x4 (&acc)[2][2][4][2], const Unit& u, int wr, int wc, int fr, int fq) const {
        const int row0 = u.pm * BM + wr * 64 + fr, col0 = u.pn * HALF + wc * 32 + 8 * fq;
#pragma unroll
        for (int ai = 0; ai < 2; ++ai)
#pragma unroll
            for (int m = 0; m < 4; ++m) {
                const int row = row0 + ai * HALF + m * 16; const float rs = ROWSCALE ? row_rstd(rowss, row) : 1.f, rse = -rs * LOG2E, rsq = rs * rs;
                f32x4 hv[2];
#pragma unroll
                for (int n = 0; n < 2; ++n) { const f32x4 g = acc[ai][0][m][n], t = g * rse; f32x4 d;
#pragma unroll
                    for (int e = 0; e < 4; ++e) d[e] = __builtin_amdgcn_exp2f(t[e]);
                    d = d + 1.0f;
#pragma unroll
                    for (int e = 0; e < 4; ++e) d[e] = __builtin_amdgcn_rcpf(d[e]);
                    hv[n] = (g * acc[ai][1][m][n]) * d; if (ROWSCALE) hv[n] = hv[n] * rsq; }
                u32x4 w; w.x = cvt_pk_bf16(hv[0][0], hv[0][1]); w.y = cvt_pk_bf16(hv[0][2], hv[0][3]); w.z = cvt_pk_bf16(hv[1][0], hv[1][1]); w.w = cvt_pk_bf16(hv[1][2], hv[1][3]);
                *(u32x4*)(H + (size_t)row * ldh + col0) = w; }
    }
};
template <int MODE> struct EpiResH {
    static constexpr bool TWOSEG = false; static constexpr bool PERM = true;
    const float* xf; bf16_t* H; float* outf; int ldc; float alpha; float* rowss;
    __device__ __forceinline__ void operator()(const f32x4 (&acc)[2][2][4][2], const Unit& u, int wr, int wc, int fr, int fq) const {
        const int row0 = u.pm * BM + wr * 64 + fr, col0 = u.pn * BM + wc * 32 + 8 * fq;
#pragma unroll
        for (int ai = 0; ai < 2; ++ai) {
            f32x4 b0[4][2], b1[4][2];
#pragma unroll
            for (int m = 0; m < 4; ++m)
#pragma unroll
                for (int bj = 0; bj < 2; ++bj) { const size_t off = (size_t)(row0 + ai * HALF + m * 16) * ldc + col0 + bj * HALF;
                    if (MODE == 0) { b0[m][bj] = *(const f32x4*)(xf + off); b1[m][bj] = *(const f32x4*)(xf + off + 4); }
                    else { const u32x4 hv = *(const u32x4*)(H + off); b0[m][bj] = (f32x4){bf_lo(hv.x), bf_hi(hv.x), bf_lo(hv.y), bf_hi(hv.y)}; b1[m][bj] = (f32x4){bf_lo(hv.z), bf_hi(hv.z), bf_lo(hv.w), bf_hi(hv.w)}; } }
            asm volatile("" ::: "memory");
#pragma unroll
            for (int m = 0; m < 4; ++m) { const int row = row0 + ai * HALF + m * 16; float s = 0.f;
#pragma unroll
                for (int bj = 0; bj < 2; ++bj) { const size_t off = (size_t)row * ldc + col0 + bj * HALF;
                    const f32x4 al4 = {alpha, alpha, alpha, alpha}; const f32x4 h0 = __builtin_elementwise_fma(acc[ai][bj][m][0], al4, b0[m][bj]), h1 = __builtin_elementwise_fma(acc[ai][bj][m][1], al4, b1[m][bj]);
                    if (MODE == 2) { *(f32x4*)(outf + off) = h0; *(f32x4*)(outf + off + 4) = h1; }
                    else { u32x4 w; w.x = cvt_pk_bf16(h0.x, h0.y); w.y = cvt_pk_bf16(h0.z, h0.w); w.z = cvt_pk_bf16(h1.x, h1.y); w.w = cvt_pk_bf16(h1.z, h1.w); *(u32x4*)(H + off) = w;
                        s = sq2bf(w.x, sq2bf(w.y, sq2bf(w.z, sq2bf(w.w, s)))); } }
                if (MODE != 2) { s = xsum32(xsum16(s)); if (fq == 0) atomicAdd(rowss + row, s); } }
            asm volatile("" ::: "memory");
        }
    }
};
template <bool COLSCALE> struct EpiBf16S {
    static constexpr bool TWOSEG = false; static constexpr bool PERM = true;
    bf16_t* O; int ldc; const float* colscale;
    __device__ __forceinline__ void operator()(const f32x4 (&acc)[2][2][4][2], const Unit& u, int wr, int wc, int fr, int fq) const {
        const int row0 = u.pm * BM + wr * 64 + fr, col0 = u.pn * BM + wc * 32 + 8 * fq;
        f32x4 sv[2][2];
#pragma unroll
        for (int bj = 0; bj < 2; ++bj)
#pragma unroll
            for (int n = 0; n < 2; ++n) sv[bj][n] = COLSCALE ? *(const f32x4*)(colscale + col0 + bj * HALF + 4 * n) : (f32x4){1.f, 1.f, 1.f, 1.f};
#pragma unroll
        for (int ai = 0; ai < 2; ++ai)
#pragma unroll
            for (int m = 0; m < 4; ++m) { const int row = row0 + ai * HALF + m * 16; bf16_t* rowp = O + (size_t)row * ldc + col0;
#pragma unroll
                for (int bj = 0; bj < 2; ++bj) { f32x4 v0 = acc[ai][bj][m][0], v1 = acc[ai][bj][m][1]; if (COLSCALE) { v0 = v0 * sv[bj][0]; v1 = v1 * sv[bj][1]; }
                    u32x4 w; w.x = cvt_pk_bf16(v0[0], v0[1]); w.y = cvt_pk_bf16(v0[2], v0[3]); w.z = cvt_pk_bf16(v1[0], v1[1]); w.w = cvt_pk_bf16(v1[2], v1[3]);
                    *(u32x4*)(rowp + bj * HALF) = w; } }
    }
};
template <bool ADD> struct EpiMerge {
    static constexpr bool TWOSEG = false; static constexpr bool PERM = true;
    bf16_t* O; int ldc; const bf16_t* gate; int ldg;
    __device__ __forceinline__ void operator()(const f32x4 (&acc)[2][2][4][2], const Unit& u, int wr, int wc, int fr, int fq) const {
        const int row0 = u.pm * BM + wr * 64 + fr, col0 = u.pn * BM + wc * 32 + 8 * fq;
#pragma unroll
        for (int ai = 0; ai < 2; ++ai) {
            u32x4 gvv[4][2], ovv[4][2];
#pragma unroll
            for (int m = 0; m < 4; ++m)
#pragma unroll
                for (int bj = 0; bj < 2; ++bj) { const size_t r = (size_t)(row0 + ai * HALF + m * 16);
                    gvv[m][bj] = *(const u32x4*)(gate + r * ldg + col0 + bj * HALF);
                    if (ADD) ovv[m][bj] = *(const u32x4*)(O + r * ldc + col0 + bj * HALF); else ovv[m][bj] = (u32x4){0u, 0u, 0u, 0u}; }
            asm volatile("" ::: "memory");
#pragma unroll
            for (int m = 0; m < 4; ++m) { const size_t r = (size_t)(row0 + ai * HALF + m * 16);
#pragma unroll
                for (int bj = 0; bj < 2; ++bj) {
                    const u32x4 gv = gvv[m][bj], ov = ovv[m][bj];
                    const f32x4 a0 = acc[ai][bj][m][0], a1 = acc[ai][bj][m][1];
                    float v[8];
                    v[0] = sigmoidf_(bf_lo(gv.x)) * a0[0]; v[1] = sigmoidf_(bf_hi(gv.x)) * a0[1]; v[2] = sigmoidf_(bf_lo(gv.y)) * a0[2]; v[3] = sigmoidf_(bf_hi(gv.y)) * a0[3];
                    v[4] = sigmoidf_(bf_lo(gv.z)) * a1[0]; v[5] = sigmoidf_(bf_hi(gv.z)) * a1[1]; v[6] = sigmoidf_(bf_lo(gv.w)) * a1[2]; v[7] = sigmoidf_(bf_hi(gv.w)) * a1[3];
                    if (ADD) { v[0] += bf_lo(ov.x); v[1] += bf_hi(ov.x); v[2] += bf_lo(ov.y); v[3] += bf_hi(ov.y); v[4] += bf_lo(ov.z); v[5] += bf_hi(ov.z); v[6] += bf_lo(ov.w); v[7] += bf_hi(ov.w); }
                    u32x4 w; w.x = cvt_pk_bf16(v[0], v[1]); w.y = cvt_pk_bf16(v[2], v[3]); w.z = cvt_pk_bf16(v[4], v[5]); w.w = cvt_pk_bf16(v[6], v[7]);
                    *(u32x4*)(O + r * ldc + col0 + bj * HALF) = w; } }
            asm volatile("" ::: "memory");
        }
    }
};
__device__ __forceinline__ unsigned pack_u8x4(float a, float b, float c, float d) {
    return (unsigned)(a * 255.f + 0.5f) | ((unsigned)(b * 255.f + 0.5f) << 8) | ((unsigned)(c * 255.f + 0.5f) << 16) | ((unsigned)(d * 255.f + 0.5f) << 24); }
__device__ __forceinline__ void unpack_u8x8(unsigned lo, unsigned hi, float (&f)[8]) {
    f[0] = (float)(lo & 0xffu); f[1] = (float)((lo >> 8) & 0xffu); f[2] = (float)((lo >> 16) & 0xffu); f[3] = (float)(lo >> 24);
    f[4] = (float)(hi & 0xffu); f[5] = (float)((hi >> 8) & 0xffu); f[6] = (float)((hi >> 16) & 0xffu); f[7] = (float)(hi >> 24); }
struct EpiMerge2 {
    static constexpr bool TWOSEG = true; static constexpr bool PERM = true;
    bf16_t* O; int ldc; const unsigned char* gq; size_t gstride;
    __device__ __forceinline__ void mid(f32x4 (&acc)[2][2][4][2], const Unit& u, int wr, int wc, int fr, int fq) const {
        const int row0 = u.pm * BM + wr * 64 + fr; const size_t lo = (size_t)u.pn * 256 + (wc * 4 + fq) * 16;
#pragma unroll
        for (int ai = 0; ai < 2; ++ai) {
            u32x4 pv[4], mv[4];
#pragma unroll
            for (int m = 0; m < 4; ++m) { const size_t o = (size_t)(row0 + ai * HALF + m * 16) * 4096 + lo; pv[m] = *(const u32x4*)(gq + o); mv[m] = *(const u32x4*)(gq + gstride + o); }
            asm volatile("" ::: "memory");
#pragma unroll
            for (int m = 0; m < 4; ++m) { float a[8], b[8];
                unpack_u8x8(pv[m].x, pv[m].y, a); unpack_u8x8(mv[m].x, mv[m].y, b);
#pragma unroll
                for (int e = 0; e < 8; ++e) acc[ai][0][m][e >> 2][e & 3] *= a[e] * __builtin_amdgcn_rcpf(fmaxf(b[e], 0.5f));
                unpack_u8x8(pv[m].z, pv[m].w, a); unpack_u8x8(mv[m].z, mv[m].w, b);
#pragma unroll
                for (int e = 0; e < 8; ++e) acc[ai][1][m][e >> 2][e & 3] *= a[e] * __builtin_amdgcn_rcpf(fmaxf(b[e], 0.5f)); }
        }
    }
    __device__ __forceinline__ void operator()(const f32x4 (&acc)[2][2][4][2], const Unit& u, int wr, int wc, int fr, int fq) const {
        const int row0 = u.pm * BM + wr * 64 + fr, col0 = u.pn * BM + wc * 32 + 8 * fq; const size_t lo = (size_t)u.pn * 256 + (wc * 4 + fq) * 16;
#pragma unroll
        for (int ai = 0; ai < 2; ++ai) {
            u32x4 mv[4];
#pragma unroll
            for (int m = 0; m < 4; ++m) mv[m] = *(const u32x4*)(gq + gstride + (size_t)(row0 + ai * HALF + m * 16) * 4096 + lo);
            asm volatile("" ::: "memory");
#pragma unroll
            for (int m = 0; m < 4; ++m) { float b[8], v[8];
                unpack_u8x8(mv[m].x, mv[m].y, b);
#pragma unroll
                for (int e = 0; e < 8; ++e) v[e] = fmaxf(b[e], 0.5f) * (1.f / 255.f) * acc[ai][0][m][e >> 2][e & 3];
                *(u32x4*)(O + (size_t)(row0 + ai * HALF + m * 16) * ldc + col0) = pack8(v);
                unpack_u8x8(mv[m].z, mv[m].w, b);
#pragma unroll
                for (int e = 0; e < 8; ++e) v[e] = fmaxf(b[e], 0.5f) * (1.f / 255.f) * acc[ai][1][m][e >> 2][e & 3];
                *(u32x4*)(O + (size_t)(row0 + ai * HALF + m * 16) * ldc + col0 + HALF) = pack8(v); }
        }
    }
};
struct EpiWin {
    static constexpr bool TWOSEG = false; static constexpr bool PERM = true;
    bf16_t* Zb; int ldz; unsigned char* gq; size_t gstride; const float* rowss;
    __device__ __forceinline__ void operator()(const f32x4 (&acc)[2][2][4][2], const Unit& u, int wr, int wc, int fr, int fq) const {
        const int row0 = u.pm * BM + wr * 64 + fr;
        if (u.pn >= 14 && u.pn < 46) {
            const int which = u.pn >= 30, t = u.pn - (which ? 30 : 14);
            unsigned char* base = gq + (size_t)which * gstride + (size_t)t * 256 + (wc * 4 + fq) * 16;
#pragma unroll
            for (int ai = 0; ai < 2; ++ai)
#pragma unroll
                for (int m = 0; m < 4; ++m) { const int row = row0 + ai * HALF + m * 16; const float rse = -row_rstd(rowss, row) * LOG2E;
                    unsigned q[2][2];
#pragma unroll
                    for (int bj = 0; bj < 2; ++bj)
#pragma unroll
                        for (int n = 0; n < 2; ++n) { f32x4 t = acc[ai][bj][m][n] * rse;
#pragma unroll
                            for (int e = 0; e < 4; ++e) t[e] = __builtin_amdgcn_exp2f(t[e]);
                            t = t + 1.0f;
#pragma unroll
                            for (int e = 0; e < 4; ++e) t[e] = __builtin_amdgcn_rcpf(t[e]);
                            t = t * 255.f + 0.5f;
                            q[bj][n] = (unsigned)t[0] | ((unsigned)t[1] << 8) | ((unsigned)t[2] << 16) | ((unsigned)t[3] << 24); }
                    u32x4 w; w.x = q[0][0]; w.y = q[0][1]; w.z = q[1][0]; w.w = q[1][1];
                    *(u32x4*)(base + (size_t)row * 4096) = w; }
        } else {
            const int col0 = u.pn * BM + wc * 32 + 8 * fq;
#pragma unroll
            for (int ai = 0; ai < 2; ++ai)
#pragma unroll
                for (int m = 0; m < 4; ++m) { const int row = row0 + ai * HALF + m * 16; const float rs = row_rstd(rowss, row); bf16_t* rowp = Zb + (size_t)row * ldz + col0;
#pragma unroll
                    for (int bj = 0; bj < 2; ++bj) { const f32x4 v0 = acc[ai][bj][m][0] * rs, v1 = acc[ai][bj][m][1] * rs;
                        u32x4 w; w.x = cvt_pk_bf16(v0[0], v0[1]); w.y = cvt_pk_bf16(v0[2], v0[3]); w.z = cvt_pk_bf16(v1[0], v1[1]); w.w = cvt_pk_bf16(v1[2], v1[3]);
                        *(u32x4*)(rowp + bj * HALF) = w; } }
        }
    }
};
struct EpiKV {
    static constexpr bool TWOSEG = false; static constexpr bool PERM = true;
    bf16_t* O; int ldc; const float* gain; LAS float* tab;
    __device__ __forceinline__ void operator()(const f32x4 (&acc)[2][2][4][2], const Unit& u, int wr, int wc, int fr, int fq) const {
        const int row0 = u.pm * BM + wr * 64 + fr, col0 = u.pn * BM + wc * 32 + 8 * fq;
#pragma unroll
        for (int ai = 0; ai < 2; ++ai)
#pragma unroll
            for (int m = 0; m < 4; ++m) { const f32x4 a = acc[ai][0][m][0], b = acc[ai][0][m][1];
                float s = (a.x * a.x + a.y * a.y) + (a.z * a.z + a.w * a.w) + (b.x * b.x + b.y * b.y) + (b.z * b.z + b.w * b.w);
                s = xsum32(xsum16(s));
                if (fq == 0) tab[(ai * HALF + wr * 64 + m * 16 + fr) * 4 + wc] = s; }
        asm volatile("s_waitcnt lgkmcnt(0)" ::: "memory"); __builtin_amdgcn_s_barrier(); asm volatile("" ::: "memory");
        f32x4 g0 = *(const f32x4*)(gain + wc * 32 + 8 * fq), g1 = *(const f32x4*)(gain + wc * 32 + 8 * fq + 4);
#pragma unroll
        for (int ai = 0; ai < 2; ++ai)
#pragma unroll
            for (int m = 0; m < 4; ++m) { const int row = row0 + ai * HALF + m * 16;
                const f32x4 t = *(const LAS f32x4*)(tab + (ai * HALF + wr * 64 + m * 16 + fr) * 4);
                const float rs = rsqrtf(((t.x + t.y) + (t.z + t.w)) * (1.f / 128.f) + 1e-6f);
                bf16_t* rowp = O + (size_t)row * ldc + col0;
                { const f32x4 v0 = acc[ai][0][m][0] * g0 * rs, v1 = acc[ai][0][m][1] * g1 * rs;
                  u32x4 w; w.x = cvt_pk_bf16(v0[0], v0[1]); w.y = cvt_pk_bf16(v0[2], v0[3]); w.z = cvt_pk_bf16(v1[0], v1[1]); w.w = cvt_pk_bf16(v1[2], v1[3]); *(u32x4*)rowp = w; }
                { const f32x4 v0 = acc[ai][1][m][0], v1 = acc[ai][1][m][1];
                  u32x4 w; w.x = cvt_pk_bf16(v0[0], v0[1]); w.y = cvt_pk_bf16(v0[2], v0[3]); w.z = cvt_pk_bf16(v1[0], v1[1]); w.w = cvt_pk_bf16(v1[2], v1[3]); *(u32x4*)(rowp + HALF) = w; } }
        asm volatile("s_waitcnt lgkmcnt(0)" ::: "memory"); __builtin_amdgcn_s_barrier(); asm volatile("" ::: "memory");
    }
};
struct EpiF32Split {
    static constexpr bool TWOSEG = false; static constexpr bool PERM = false;
    float* O; int ldc; int tmask, tshift; size_t sstride; const float* rowss;
    __device__ __forceinline__ void operator()(const f32x4 (&acc)[2][2][4][2], const Unit& u, int wr, int wc, int fr, int fq) const {
        float* base = O + (size_t)(u.pn >> tshift) * sstride;
        const int row0 = u.pm * BM + wr * 64 + fr, col0 = (u.pn & tmask) * BM + wc * 32 + 4 * fq;
#pragma unroll
        for (int ai = 0; ai < 2; ++ai)
#pragma unroll
            for (int m = 0; m < 4; ++m) { const int row = row0 + ai * HALF + m * 16; const float rs = row_rstd(rowss, row); float* rowp = base + (size_t)row * ldc + col0;
#pragma unroll
                for (int bj = 0; bj < 2; ++bj)
#pragma unroll
                    for (int n = 0; n < 2; ++n) *(f32x4*)(rowp + bj * HALF + n * 16) = acc[ai][bj][m][n] * rs; }
    }
};

template <class Epi, class Sched, int PF = 0, bool ALIGN_EPI = true>
__device__ __forceinline__ void gemm_phase(LAS unsigned char* lds, const Gemm g, const Sched& S, const Epi& E) {
    int tid = threadIdx.x; asm volatile("" : "+v"(tid));
    const int wid = __builtin_amdgcn_readfirstlane(tid >> 6), lane = tid & 63, wr = wid >> 2, wc = wid & 3, fr = lane & 15, fq = lane >> 4;
    const int K = g.K, nt = K / BK;
    unsigned voffA[2], voffB[2];
#pragma unroll
    for (int i = 0; i < 2; ++i) { int R, C; stage_rc(tid * 16 + i * 8192, R, C); const int Rb = Epi::PERM ? ((R & ~31) + perm32(R & 31)) : R;
        voffA[i] = (unsigned)(R * g.lda + C) * 2u; voffB[i] = (unsigned)(Rb * g.ldb + C) * 2u; }
    const size_t kstep = (size_t)(BK * 2);
    const size_t hstepA = (size_t)HALF * g.lda * 2, hstepB = (size_t)HALF * g.ldb * 2;
    const unsigned ldsw = (unsigned)wid * 1024u;
    const int aoff = lds_byte(wr * 64 + fr, fq * 8), boff = lds_byte(wc * 32 + fr, fq * 8);
#define PG8_SA(b, h) (((b) * 2 + (h)) * HTB)
#define PG8_SB(b, h) ((4 + (b) * 2 + (h)) * HTB)
#define PG8_STAGE(bufoff, gbase, voff) do { _Pragma("unroll") for (int _i = 0; _i < 2; ++_i) \
        __builtin_amdgcn_global_load_lds((const unsigned*)((const char*)(gbase) + (voff)[_i]), (LAS unsigned*)(lds + (bufoff) + ldsw + _i * 8192), 16, 0, 0); } while (0)
#define PG8_LDA(dst, b, h) do { _Pragma("unroll") for (int m = 0; m < 4; ++m) _Pragma("unroll") for (int k = 0; k < 2; ++k) dst[m][k] = *(const LAS bf16x8*)(lds + PG8_SA(b, h) + aoff + m * 2048 + k * 1024); } while (0)
#define PG8_LDB(dst, b, h) do { _Pragma("unroll") for (int n = 0; n < 2; ++n) _Pragma("unroll") for (int k = 0; k < 2; ++k) dst[n][k] = *(const LAS bf16x8*)(lds + PG8_SB(b, h) + boff + n * 2048 + k * 1024); } while (0)
#define PG8_MMA(ai, bj, At, Bt) do { __builtin_amdgcn_s_setprio(1); _Pragma("unroll") for (int m = 0; m < 4; ++m) _Pragma("unroll") for (int n = 0; n < 2; ++n) _Pragma("unroll") for (int k = 0; k < 2; ++k) \
        acc[ai][bj][m][n] = __builtin_amdgcn_mfma_f32_16x16x32_bf16(Bt[n][k], At[m][k], acc[ai][bj][m][n], 0, 0, 0); __builtin_amdgcn_s_setprio(0); } while (0)
#define PG8_WAIT_V(n) asm volatile("s_waitcnt vmcnt(" #n ")" ::: "memory")
#define PG8_WAIT_L(n) asm volatile("s_waitcnt lgkmcnt(" #n ")" ::: "memory")
#define PG8_BAR __builtin_amdgcn_s_barrier()
#define PG8_SCHED __builtin_amdgcn_sched_barrier(0)
#define PG8_APTR(u) ((const char*)((u).seg ? g.A2 : g.A) + ((size_t)(u).pm * BM * g.lda + (size_t)((u).pn >> g.ashift) * g.astride) * 2)
#define PG8_BPTR(u) ((const char*)((u).seg ? g.Bt2 : g.Bt) + ((size_t)((u).pn & g.bmask) * BM * g.ldb + (size_t)((u).pn >> g.ashift) * g.bstride) * 2)
#define PG8_KITER(t) do { \
            const bool last = (t == nt - 2); \
            const char* a1 = cA + (size_t)(t + 1) * kstep; \
            const char* a2 = last ? nA : cA + (size_t)(t + 2) * kstep; const char* b2 = last ? nB : cB + (size_t)(t + 2) * kstep; \
            const char* a3 = a2 + kstep; const char* b3 = b2 + kstep; \
              \
            PG8_LDB(B0, 0, 0); PG8_LDB(B1, 0, 1); PG8_SCHED; PG8_LDA(At, 0, 0); PG8_STAGE(PG8_SA(1, 1), a1 + hstepA, voffA); \
            PG8_WAIT_VK(); PG8_WAIT_L(0); PG8_BAR; PG8_MMA(0, 0, At, B0); PG8_MMA(0, 1, At, B1); PG8_BAR; PG8_SCHED; \
              \
            PG8_LDA(At, 0, 1); PG8_STAGE(PG8_SB(0, 0), b2, voffB); PG8_STAGE(PG8_SB(0, 1), b2 + hstepB, voffB); PG8_STAGE(PG8_SA(0, 0), a2, voffA); \
            if constexpr (PF > 0) { const int kt = t + 2 + PF; const char* p = kt < nt ? pfc + (size_t)kt * kstep : pfn + (size_t)(kt - nt) * kstep; PG8_TOUCH(p); } \
            PG8_WAIT_VK(); PG8_WAIT_L(0); PG8_BAR; PG8_MMA(1, 0, At, B0); PG8_MMA(1, 1, At, B1); PG8_BAR; PG8_SCHED; \
              \
            PG8_LDB(B0, 1, 0); PG8_LDB(B1, 1, 1); PG8_SCHED; PG8_LDA(At, 1, 0); PG8_STAGE(PG8_SA(0, 1), a2 + hstepA, voffA); \
            PG8_WAIT_VK(); PG8_WAIT_L(0); PG8_BAR; PG8_MMA(0, 0, At, B0); PG8_MMA(0, 1, At, B1); PG8_BAR; PG8_SCHED; \
              \
            PG8_LDA(At, 1, 1); PG8_STAGE(PG8_SB(1, 0), b3, voffB); PG8_STAGE(PG8_SB(1, 1), b3 + hstepB, voffB); PG8_STAGE(PG8_SA(1, 0), a3, voffA); \
            if constexpr (PF > 0) { const int kt = t + 3 + PF; const char* p = kt < nt ? pfc + (size_t)kt * kstep : pfn + (size_t)(kt - nt) * kstep; PG8_TOUCH(p); } \
            PG8_WAIT_VK(); PG8_WAIT_L(0); PG8_BAR; PG8_MMA(1, 0, At, B0); PG8_MMA(1, 1, At, B1); PG8_BAR; PG8_SCHED; \
        } while (0)
    Unit cur, nxt; int ui = 0;
    if (!S.next(0, cur)) return;
    f32x4 acc[2][2][4][2];
#pragma unroll
    for (int a = 0; a < 2; ++a)
#pragma unroll
        for (int b = 0; b < 2; ++b)
#pragma unroll
            for (int m = 0; m < 4; ++m)
#pragma unroll
                for (int n = 0; n < 2; ++n) acc[a][b][m][n] = (f32x4){0.f, 0.f, 0.f, 0.f};
    bf16x8 At[4][2], B0[2][2], B1[2][2];
    const char* cA = PG8_APTR(cur); const char* cB = PG8_BPTR(cur);
    unsigned pfd = 0u;
    const size_t pfrow = (tid < 256) ? (size_t)tid * g.lda * 2 : (size_t)(tid - 256) * g.ldb * 2;
#define PG8_PFPTR(pa, pb) (((tid < 256) ? (pa) : (pb)) + pfrow)
#define PG8_TOUCH(p) asm volatile("global_load_dword %0, %1, off" : "+v"(pfd) : "v"(p) : "memory")
#define PG8_WAIT_VK() do { if constexpr (PF > 0) PG8_WAIT_V(9); else PG8_WAIT_V(8); } while (0)
    PG8_STAGE(PG8_SB(0, 0), cB, voffB); PG8_STAGE(PG8_SB(0, 1), cB + hstepB, voffB); PG8_STAGE(PG8_SA(0, 0), cA, voffA); PG8_STAGE(PG8_SA(0, 1), cA + hstepA, voffA);
    if (wr == 1) PG8_BAR;
    PG8_WAIT_V(2); PG8_BAR;
    PG8_STAGE(PG8_SB(1, 0), cB + kstep, voffB); PG8_STAGE(PG8_SA(1, 0), cA + kstep, voffA); PG8_STAGE(PG8_SB(1, 1), cB + hstepB + kstep, voffB);
    PG8_WAIT_V(6); PG8_BAR;
    if constexpr (PF > 0) { const char* p0 = PG8_PFPTR(cA, cB) + (size_t)(2 + PF) * kstep; PG8_TOUCH(p0); }
    for (;;) {
        const bool has_next = S.next(ui + 1, nxt);
        const char* nA = has_next ? PG8_APTR(nxt) : cA; const char* nB = has_next ? PG8_BPTR(nxt) : cB;
        const char* pfc = PG8_PFPTR(cA, cB); const char* pfn = PG8_PFPTR(nA, nB);
        PG8_KITER(0);
        for (int t = 2; t < nt; t += 2) PG8_KITER(t);
        if constexpr (ALIGN_EPI) { if (wr == 0) PG8_BAR; }
#if defined(PROBE_MODE) && PROBE_MODE == 2
        if (blockIdx.x == 0 && threadIdx.x == 0) { volatile LAS unsigned long long* pw_ = (volatile LAS unsigned long long*)(lds + 135168); if (pw_[4]) { pw_[3] += __builtin_amdgcn_s_memrealtime() - pw_[5]; } }
#endif
        bool keep = false;
        {
            int te = threadIdx.x; asm volatile("" : "+v"(te));
            const int widE = __builtin_amdgcn_readfirstlane(te >> 6), laneE = te & 63, wrE = widE >> 2, wcE = widE & 3, frE = laneE & 15, fqE = laneE >> 4;
            if constexpr (Epi::TWOSEG) { if (cur.seg == 0) { E.mid(acc, cur, wrE, wcE, frE, fqE); keep = true; } else E(acc, cur, wrE, wcE, frE, fqE); }
            else E(acc, cur, wrE, wcE, frE, fqE); }
#if defined(PROBE_MODE) && PROBE_MODE == 2
        if (blockIdx.x == 0 && threadIdx.x == 0) { volatile LAS unsigned long long* pw_ = (volatile LAS unsigned long long*)(lds + 135168); if (pw_[4]) { pw_[5] = __builtin_amdgcn_s_memrealtime(); } }
#endif
        if (!has_next) break;
        if (!keep) {
#pragma unroll
        for (int a = 0; a < 2; ++a)
#pragma unroll
            for (int b = 0; b < 2; ++b)
#pragma unroll
                for (int m = 0; m < 4; ++m)
#pragma unroll
                    for (int n = 0; n < 2; ++n) acc[a][b][m][n] = (f32x4){0.f, 0.f, 0.f, 0.f};
        }
        cur = nxt; cA = nA; cB = nB; ++ui;
        if constexpr (ALIGN_EPI) { if (wr == 1) PG8_BAR; }
    }
    PG8_WAIT_V(0);
    asm volatile("" :: "v"(pfd));
    if constexpr (!ALIGN_EPI) { if (wr == 0) PG8_BAR; }
    PG8_BAR;
#undef PG8_SA
#undef PG8_SB
#undef PG8_STAGE
#undef PG8_LDA
#undef PG8_LDB
#undef PG8_MMA
#undef PG8_WAIT_V
#undef PG8_WAIT_L
#undef PG8_BAR
#undef PG8_SCHED
#undef PG8_APTR
#undef PG8_BPTR
#undef PG8_PFPTR
#undef PG8_TOUCH
#undef PG8_WAIT_VK
#undef PG8_KITER
}
}

namespace att {
constexpr int KVBLK = 64, QBLK = 32, NW = 8;
constexpr int SHM_V = KVBLK * 128 * 2;
constexpr float THR2 = 11.5f;
#define ATT_KSWZ(row, colB, KROW) ((row) * (KROW) + (colB))
#define ATT_SBAR() __builtin_amdgcn_sched_barrier(0)
__device__ __forceinline__ int crow(int r, int hi) { return (r & 3) + 8 * (r >> 2) + 4 * hi; }

__device__ __forceinline__ void partialSM(f32x16& p0, f32x16& p1, float& m_reg, float& mn, float& alpha) {
    float pmax = p0[0];
#pragma unroll
    for (int r = 1; r < 16; ++r) pmax = fmaxf(pmax, p0[r]);
#pragma unroll
    for (int r = 0; r < 16; ++r) pmax = fmaxf(pmax, p1[r]);
    { auto rr = __builtin_amdgcn_permlane32_swap(__float_as_uint(pmax), __float_as_uint(pmax), false, false);
      pmax = fmaxf(__uint_as_float(rr[0]), __uint_as_float(rr[1])); }
    if (__builtin_expect(__all(pmax - m_reg <= THR2), 1)) { mn = m_reg; alpha = 1.f; }
    else { mn = fmaxf(m_reg, pmax); alpha = __builtin_amdgcn_exp2f(m_reg - mn); m_reg = mn; }
#pragma unroll
    for (int r = 0; r < 16; ++r) p0[r] = p0[r] - mn;
#pragma unroll
    for (int r = 0; r < 16; ++r) p1[r] = p1[r] - mn;
#pragma unroll
    for (int r = 0; r < 16; ++r) p0[r] = __builtin_amdgcn_exp2f(p0[r]);
}
__device__ __forceinline__ void finishSM(f32x16& p0, f32x16& p1, float alpha, float& l_reg, bf16x8& pa0, bf16x8& pa1, bf16x8& pa2, bf16x8& pa3) {
#pragma unroll
    for (int r = 0; r < 16; ++r) p1[r] = __builtin_amdgcn_exp2f(p1[r]);
    float ps = 0;
#pragma unroll
    for (int r = 0; r < 16; ++r) ps += p0[r];
#pragma unroll
    for (int r = 0; r < 16; ++r) ps += p1[r];
    { auto rr = __builtin_amdgcn_permlane32_swap(__float_as_uint(ps), __float_as_uint(ps), false, false);
      ps = __uint_as_float(rr[0]) + __uint_as_float(rr[1]); }
    l_reg = l_reg * alpha + ps;
#define ATT_PK4(P, BASE, OUT) do { unsigned a0 = cvt_pk_bf16(P[BASE + 0], P[BASE + 1]), a1 = cvt_pk_bf16(P[BASE + 2], P[BASE + 3]);   \
    unsigned b0 = cvt_pk_bf16(P[BASE + 4], P[BASE + 5]), b1 = cvt_pk_bf16(P[BASE + 6], P[BASE + 7]);                              \
    auto r0 = __builtin_amdgcn_permlane32_swap(a0, b0, false, false); auto r1 = __builtin_amdgcn_permlane32_swap(a1, b1, false, false); \
    u32x4 w = {r0[0], r1[0], r0[1], r1[1]}; OUT = __builtin_bit_cast(bf16x8, w); } while (0)
    ATT_PK4(p0, 0, pa0); ATT_PK4(p0, 8, pa1); ATT_PK4(p1, 0, pa2); ATT_PK4(p1, 8, pa3);
#undef ATT_PK4
}
#ifndef QKT_PIN
#define QKT_PIN 1
#endif
template <int DK> __device__ __forceinline__ void qkt(f32x16& p0, f32x16& p1, const char* Ks, const bf16x8* qr, int r32, int hi) {
    p0 = f32x16{}; p1 = f32x16{};
    __builtin_amdgcn_s_setprio(1);
#pragma unroll
    for (int d0 = 0; d0 < DK / 16; ++d0) { const int cb = (d0 * 16 + hi * 8) * 2;
        const bf16x8 b0 = *reinterpret_cast<const bf16x8*>(Ks + ATT_KSWZ(r32, cb, DK * 2 + 16));
        const bf16x8 b1 = *reinterpret_cast<const bf16x8*>(Ks + ATT_KSWZ(32 + r32, cb, DK * 2 + 16));
        p0 = __builtin_amdgcn_mfma_f32_32x32x16_bf16(b0, qr[d0], p0, 0, 0, 0);
        p1 = __builtin_amdgcn_mfma_f32_32x32x16_bf16(b1, qr[d0], p1, 0, 0, 0);
        if (QKT_PIN && (d0 % 3) == 2) ATT_SBAR(); }
    __builtin_amdgcn_s_setprio(0);
}
template <int DK> __device__ __forceinline__ void qkt_pipe(f32x16& p0, f32x16& p1, const char* Ks, const bf16x8* qr, int r32, int hi) {
    constexpr int ND = DK / 16, KR = DK * 2 + 16;
    const char* r0 = Ks + ATT_KSWZ(r32, hi * 16, KR); const char* r1 = Ks + ATT_KSWZ(32 + r32, hi * 16, KR);
    bf16x8 ka[3], kb[3];
#define QP_LD(d, s) do { ka[s] = *reinterpret_cast<const bf16x8*>(r0 + (d) * 32); kb[s] = *reinterpret_cast<const bf16x8*>(r1 + (d) * 32); } while (0)
    QP_LD(0, 0); QP_LD(1, 1); QP_LD(2, 2); ATT_SBAR();
    p0 = f32x16{}; p1 = f32x16{};
    __builtin_amdgcn_s_setprio(1);
#pragma unroll
    for (int d0 = 0; d0 < ND; ++d0) {
        p0 = __builtin_amdgcn_mfma_f32_32x32x16_bf16(ka[d0 % 3], qr[d0], p0, 0, 0, 0);
        p1 = __builtin_amdgcn_mfma_f32_32x32x16_bf16(kb[d0 % 3], qr[d0], p1, 0, 0, 0);
        if (d0 + 3 < ND) QP_LD(d0 + 3, d0 % 3);
        ATT_SBAR(); }
    __builtin_amdgcn_s_setprio(0);
#undef QP_LD
}
__device__ __forceinline__ void cmask(f32x16& p0, f32x16& p1, int t, int qrel, int hi) {
    const float ninf = -__builtin_inff();
#pragma unroll
    for (int r = 0; r < 16; ++r) { const int k0 = 64 * t + crow(r, hi); if (k0 > qrel) p0[r] = ninf; if (k0 + 32 > qrel) p1[r] = ninf; }
}
__device__ __forceinline__ int v_st(int k, int c) { const int kk = (k & ~0xC) | ((k & 4) << 1) | ((k & 8) >> 1); return ((kk >> 3) * 4 + (c >> 5)) * 512 + ((kk & 7) * 32 + (c & 31)) * 2; }
__device__ __forceinline__ int v_rd_base(int lane) { return ((lane & 3) << 3) | (((lane >> 2) & 3) << 6) | (((lane >> 4) & 1) << 5) | (((lane >> 5) & 1) << 8); }
constexpr int v_rd_off(int d0, int ks, int half) { return d0 * 512 + ks * 4096 + half * 2048; }
template <int OFF> __device__ __forceinline__ s16x4 tr_read(int vb) {
    s16x4 r; asm volatile("ds_read_b64_tr_b16 %0, %1 offset:%2" : "=&v"(r) : "v"(vb), "i"(OFF) : "memory"); return r;
}
template <int D0> __device__ __forceinline__ void pv_one(f32x16& od, int vb, bf16x8 pa0, bf16x8 pa1, bf16x8 pa2, bf16x8 pa3) {
    const s16x4 l0 = tr_read<v_rd_off(D0, 0, 0)>(vb), h0 = tr_read<v_rd_off(D0, 0, 1)>(vb), l1 = tr_read<v_rd_off(D0, 1, 0)>(vb), h1 = tr_read<v_rd_off(D0, 1, 1)>(vb);
    const s16x4 l2 = tr_read<v_rd_off(D0, 2, 0)>(vb), h2 = tr_read<v_rd_off(D0, 2, 1)>(vb), l3 = tr_read<v_rd_off(D0, 3, 0)>(vb), h3 = tr_read<v_rd_off(D0, 3, 1)>(vb);
    asm volatile("s_waitcnt lgkmcnt(0)" ::: "memory"); ATT_SBAR();
    __builtin_amdgcn_s_setprio(1);
#define ATT_PK(L, H) (bf16x8){L[0], L[1], L[2], L[3], H[0], H[1], H[2], H[3]}
    od = __builtin_amdgcn_mfma_f32_32x32x16_bf16(pa0, ATT_PK(l0, h0), od, 0, 0, 0);
    od = __builtin_amdgcn_mfma_f32_32x32x16_bf16(pa1, ATT_PK(l1, h1), od, 0, 0, 0);
    od = __builtin_amdgcn_mfma_f32_32x32x16_bf16(pa2, ATT_PK(l2, h2), od, 0, 0, 0);
    od = __builtin_amdgcn_mfma_f32_32x32x16_bf16(pa3, ATT_PK(l3, h3), od, 0, 0, 0);
    __builtin_amdgcn_s_setprio(0);
#undef ATT_PK
}
__device__ __forceinline__ void pv_d0(f32x16* o, int vb, bf16x8 pa0, bf16x8 pa1, bf16x8 pa2, bf16x8 pa3) {
#define PV_RD(D0, S) const s16x4 l0##S = tr_read<v_rd_off(D0, 0, 0)>(vb), h0##S = tr_read<v_rd_off(D0, 0, 1)>(vb), l1##S = tr_read<v_rd_off(D0, 1, 0)>(vb), h1##S = tr_read<v_rd_off(D0, 1, 1)>(vb), \
                               l2##S = tr_read<v_rd_off(D0, 2, 0)>(vb), h2##S = tr_read<v_rd_off(D0, 2, 1)>(vb), l3##S = tr_read<v_rd_off(D0, 3, 0)>(vb), h3##S = tr_read<v_rd_off(D0, 3, 1)>(vb)
#define PV_PK(L, H) (bf16x8){L[0], L[1], L[2], L[3], H[0], H[1], H[2], H[3]}
#define PV_MM(D0, S) do { __builtin_amdgcn_s_setprio(1); o[D0] = __builtin_amdgcn_mfma_f32_32x32x16_bf16(pa0, PV_PK(l0##S, h0##S), o[D0], 0, 0, 0); o[D0] = __builtin_amdgcn_mfma_f32_32x32x16_bf16(pa1, PV_PK(l1##S, h1##S), o[D0], 0, 0, 0); \
                            o[D0] = __builtin_amdgcn_mfma_f32_32x32x16_bf16(pa2, PV_PK(l2##S, h2##S), o[D0], 0, 0, 0); o[D0] = __builtin_amdgcn_mfma_f32_32x32x16_bf16(pa3, PV_PK(l3##S, h3##S), o[D0], 0, 0, 0); __builtin_amdgcn_s_setprio(0); } while (0)
#define PV_WAIT(n) do { asm volatile("s_waitcnt lgkmcnt(" #n ")" ::: "memory"); ATT_SBAR(); } while (0)
    PV_RD(0, a); ATT_SBAR();
    PV_RD(1, b); PV_WAIT(8); PV_MM(0, a); ATT_SBAR();
    PV_RD(2, c); PV_WAIT(8); PV_MM(1, b); ATT_SBAR();
    PV_RD(3, d); PV_WAIT(8); PV_MM(2, c); ATT_SBAR();
    PV_WAIT(0); PV_MM(3, d);
#undef PV_RD
#undef PV_PK
#undef PV_MM
#undef PV_WAIT
}

template <int DK, bool CAUSAL>
__device__ __forceinline__ void attn_unit(const bf16x8 (&qr)[DK / 16], const bf16_t* __restrict__ Kn, int ldk, const bf16_t* __restrict__ Kr, int ldkr,
                                          const bf16_t* __restrict__ V, int ldv, bf16_t* __restrict__ O, int ldo, int NT, char* lds) {
    constexpr int KROW = DK * 2 + 16, SHM_K = KVBLK * KROW;
    int tid = threadIdx.x; asm volatile("" : "+v"(tid));
    const int wid = tid >> 6, lane = tid & 63, r32 = lane & 31, hi = lane >> 5;
    char* V_lds = lds; char* K_lds = lds + 2 * SHM_V;
    float* wsf = (float*)(lds + 2 * SHM_V + 2 * SHM_K) + wid * 64; float* li_l = wsf; float* al_l = wsf + 32;
    float m_reg = -1e30f, l_reg = 0; f32x16 o[4] = {};
    const int sr = tid >> 4, sc = (tid & 15) * 8, vst0 = v_st(sr, sc), vst1 = v_st(32 + sr, sc);
    const int rr = tid >> 3, rc = (tid & 7) * 8;
    const int vb0 = (int)(uintptr_t)V_lds + v_rd_base(lane);
    bf16x8 vs0, vs1, ks0, ks1, kr0;
#define SLOAD(k0) do { vs0 = *(const bf16x8*)(V + (size_t)((k0) + sr) * ldv + sc); vs1 = *(const bf16x8*)(V + (size_t)((k0) + 32 + sr) * ldv + sc); \
    ks0 = *(const bf16x8*)(Kn + (size_t)((k0) + sr) * ldk + sc); ks1 = *(const bf16x8*)(Kn + (size_t)((k0) + 32 + sr) * ldk + sc); \
    if constexpr (DK == 192) kr0 = *(const bf16x8*)(Kr + (size_t)((k0) + rr) * ldkr + rc); } while (0)
#define SWRITE(b) do { *(bf16x8*)(V_lds + (b) * SHM_V + vst0) = vs0; *(bf16x8*)(V_lds + (b) * SHM_V + vst1) = vs1; const int kc = sc * 2; \
    *(bf16x8*)(K_lds + (b) * SHM_K + ATT_KSWZ(sr, kc, KROW)) = ks0; *(bf16x8*)(K_lds + (b) * SHM_K + ATT_KSWZ(32 + sr, kc, KROW)) = ks1; \
    if constexpr (DK == 192) *(bf16x8*)(K_lds + (b) * SHM_K + ATT_KSWZ(rr, 256 + rc * 2, KROW)) = kr0; } while (0)
#define SWAIT() asm volatile("s_waitcnt vmcnt(0)" ::: "memory")
#define RESC(a) do { if (__any((a) < 1.f)) { if (hi == 0) al_l[r32] = (a); asm volatile("s_waitcnt lgkmcnt(0)" ::: "memory"); \
    _Pragma("unroll") for (int d = 0; d < 4; ++d) _Pragma("unroll") for (int r = 0; r < 16; ++r) o[d][r] *= al_l[crow(r, hi)]; } } while (0)
#define MASK(P0, P1, j) do { if (CAUSAL) { const int t_ = (j) - (NT - 4); if (t_ >= 0 && 64 * t_ + 63 > 32 * wid) cmask(P0, P1, t_, 32 * wid + r32, hi); } } while (0)
    f32x16 p0, p1; float mn, al; bf16x8 pa0, pa1, pa2, pa3;
    SLOAD(0); SWAIT(); SWRITE(0); __syncthreads();
#define ATT_STEP(j, b) do { \
        if ((j) + 1 < NT) SLOAD(((j) + 1) * KVBLK); ATT_SBAR(); \
        qkt<DK>(p0, p1, K_lds + (b) * SHM_K, qr, r32, hi); MASK(p0, p1, (j)); partialSM(p0, p1, m_reg, mn, al); RESC(al); \
        finishSM(p0, p1, al, l_reg, pa0, pa1, pa2, pa3); ATT_SBAR(); \
        pv_d0(o, vb0 + (b) * SHM_V, pa0, pa1, pa2, pa3); \
        if ((j) + 1 < NT) { SWAIT(); SWRITE((b) ^ 1); } \
        __syncthreads(); } while (0)
    for (int j = 0; j < NT; j += 2) { ATT_STEP(j, 0); ATT_STEP(j + 1, 1); }
#undef ATT_STEP
    if (hi == 0) li_l[r32] = l_reg; asm volatile("s_waitcnt lgkmcnt(0)" ::: "memory");
    float rli[16];
#pragma unroll
    for (int r = 0; r < 16; ++r) rli[r] = __builtin_amdgcn_rcpf(li_l[crow(r, hi)]);
    bf16_t* Ow = O + (size_t)(wid * QBLK) * ldo;
#pragma unroll
    for (int r = 0; r < 16; ++r) { const int orow = crow(r, hi);
#pragma unroll
        for (int d0 = 0; d0 < 4; ++d0) { const unsigned w = cvt_pk_bf16(o[d0][r] * rli[r], 0.f); Ow[(size_t)orow * ldo + d0 * 32 + r32] = (bf16_t)(w & 0xffffu); } }
    __syncthreads();
#undef SLOAD
#undef SWRITE
#undef SWAIT
#undef RESC
#undef MASK
}


template <int DK, bool CAUSAL>
__device__ __forceinline__ void attn_unit_pp(const bf16x8 (&qr)[DK / 16], const bf16_t* __restrict__ Kn, int ldk, const bf16_t* __restrict__ Kr, int ldkr,
                                             const bf16_t* __restrict__ V, int ldv, bf16_t* __restrict__ O, int ldo, int NT, char* lds) {
    constexpr int KROW = DK * 2 + 16, SHM_K = KVBLK * KROW;
    int tid = threadIdx.x; asm volatile("" : "+v"(tid));
    const int wid = __builtin_amdgcn_readfirstlane(tid >> 6), lane = tid & 63, r32 = lane & 31, hi = lane >> 5, half = wid >> 2;
    char* V_lds = lds; char* K_lds = lds + 2 * SHM_V;
    float* wsf = (float*)(lds + 2 * SHM_V + 2 * SHM_K) + wid * 64; float* li_l = wsf; float* al_l = wsf + 32;
    float m_reg = -1e30f, l_reg = 0; f32x16 o[4] = {};
    const int sr = tid >> 4, sc = (tid & 15) * 8, vst0 = v_st(sr, sc), vst1 = v_st(32 + sr, sc);
    const int rr = tid >> 3, rc = (tid & 7) * 8;
    const int vb0 = (int)(uintptr_t)V_lds + v_rd_base(lane);
    bf16x8 vs0, vs1, ks0, ks1, kr0;
    const __amdgpu_buffer_rsrc_t rsV = __builtin_amdgcn_make_buffer_rsrc((void*)V, (short)0, 0x7fffffff, 0x00020000);
    const __amdgpu_buffer_rsrc_t rsK = __builtin_amdgcn_make_buffer_rsrc((void*)Kn, (short)0, 0x7fffffff, 0x00020000);
    const __amdgpu_buffer_rsrc_t rsR = __builtin_amdgcn_make_buffer_rsrc((void*)(DK == 192 ? Kr : Kn), (short)0, 0x7fffffff, 0x00020000);
    const unsigned ovl = (unsigned)(sr * ldv + sc) * 2u, okl = (unsigned)(sr * ldk + sc) * 2u, orl = (unsigned)(rr * ldkr + rc) * 2u;
#define BLD(rs, voff, soff) __builtin_bit_cast(bf16x8, __builtin_amdgcn_raw_buffer_load_b128((rs), (voff), (soff), 0))
#define KLOAD(k0) do { const unsigned sk_ = (unsigned)(k0) * (unsigned)ldk * 2u; ks0 = BLD(rsK, okl, sk_); ks1 = BLD(rsK, okl + 64u * (unsigned)ldk, sk_); \
    if constexpr (DK == 192) kr0 = BLD(rsR, orl, (unsigned)(k0) * (unsigned)ldkr * 2u); } while (0)
#define VLOAD(k0) do { const unsigned sv_ = (unsigned)(k0) * (unsigned)ldv * 2u; vs0 = BLD(rsV, ovl, sv_); vs1 = BLD(rsV, ovl + 64u * (unsigned)ldv, sv_); } while (0)
#define KWRITE(boff) do { const int kc = sc * 2; *(bf16x8*)(K_lds + (boff) + ATT_KSWZ(sr, kc, KROW)) = ks0; *(bf16x8*)(K_lds + (boff) + ATT_KSWZ(32 + sr, kc, KROW)) = ks1; \
    if constexpr (DK == 192) *(bf16x8*)(K_lds + (boff) + ATT_KSWZ(rr, 256 + rc * 2, KROW)) = kr0; } while (0)
#define VWRITE(boff) do { *(bf16x8*)(V_lds + (boff) + vst0) = vs0; *(bf16x8*)(V_lds + (boff) + vst1) = vs1; } while (0)
#define VMWAIT() asm volatile("s_waitcnt vmcnt(0)" ::: "memory")
#define PPBAR() do { ATT_SBAR(); asm volatile("s_waitcnt lgkmcnt(0)" ::: "memory"); __builtin_amdgcn_s_barrier(); asm volatile("" ::: "memory"); ATT_SBAR(); } while (0)
#define RESC(a) do { if (__any((a) < 1.f)) { if (hi == 0) al_l[r32] = (a); asm volatile("s_waitcnt lgkmcnt(0)" ::: "memory"); \
    _Pragma("unroll") for (int d = 0; d < 4; ++d) _Pragma("unroll") for (int r = 0; r < 16; ++r) o[d][r] *= al_l[crow(r, hi)]; } } while (0)
#define MASK(P0, P1, j) do { if (CAUSAL) { const int t_ = (j) - (NT - 4); if (t_ >= 0 && 64 * t_ + 63 > 32 * wid) cmask(P0, P1, t_, 32 * wid + r32, hi); } } while (0)
    f32x16 p0, p1; float mn, al; bf16x8 pa0, pa1, pa2, pa3;
    KLOAD(KVBLK); { const bf16x8 t0 = ks0, t1 = ks1, t2 = kr0;
      KLOAD(0); VLOAD(0); VMWAIT(); KWRITE(0); VWRITE(0);
      ks0 = t0; ks1 = t1; if constexpr (DK == 192) kr0 = t2; KWRITE(SHM_K); }
    PPBAR();
    { const int kt0 = 1 + half, vt0 = half; if (kt0 < NT) KLOAD(kt0 * KVBLK); if (vt0 < NT) VLOAD(vt0 * KVBLK); }
    if (half == 1) PPBAR();
#define PP_STEP(s, PAR) do { \
        const int kt_ = (s) + 1 + half, vt_ = (s) + half; \
        if ((s) < NT) qkt_pipe<DK>(p0, p1, K_lds + (PAR) * SHM_K, qr, r32, hi); \
        if ((s) >= 1) pv_d0(o, vb0 + ((PAR) ^ 1) * SHM_V, pa0, pa1, pa2, pa3); \
        PPBAR(); \
        if ((s) < NT) { MASK(p0, p1, (s)); partialSM(p0, p1, m_reg, mn, al); RESC(al); finishSM(p0, p1, al, l_reg, pa0, pa1, pa2, pa3); } \
        VMWAIT(); \
        if (kt_ < NT) KWRITE((kt_ & 1) * SHM_K); if (vt_ < NT) VWRITE((vt_ & 1) * SHM_V); \
        if (kt_ + 1 < NT) KLOAD((kt_ + 1) * KVBLK); if (vt_ + 1 < NT) VLOAD((vt_ + 1) * KVBLK);        \
        PPBAR(); } while (0)
    for (int s = 0; s < NT; s += 2) { PP_STEP(s, 0); PP_STEP(s + 1, 1); }
    PP_STEP(NT, 0);
#undef PP_STEP
    if (half == 0) PPBAR();
    {
        int t2 = threadIdx.x; asm volatile("" : "+v"(t2));
        const int wid2 = t2 >> 6, r2 = t2 & 31, hi2 = (t2 >> 5) & 1;
        float* li2 = (float*)(lds + 2 * SHM_V + 2 * SHM_K) + wid2 * 64;
        if (hi2 == 0) li2[r2] = l_reg; asm volatile("s_waitcnt lgkmcnt(0)" ::: "memory");
        bf16_t* Ow = O + (size_t)(wid2 * QBLK) * ldo + r2;
#pragma unroll
        for (int r = 0; r < 16; ++r) { const int orow = crow(r, hi2); const float rl = __builtin_amdgcn_rcpf(li2[orow]);
#pragma unroll
            for (int d0 = 0; d0 < 4; ++d0) { const unsigned w = cvt_pk_bf16(o[d0][r] * rl, 0.f); Ow[(size_t)orow * ldo + d0 * 32] = (bf16_t)(w & 0xffffu); } }
    }
    PPBAR();
#undef KLOAD
#undef BLD
#undef VLOAD
#undef KWRITE
#undef VWRITE
#undef VMWAIT
#undef PPBAR
#undef RESC
#undef MASK
}
}

#define XB_TMO      128
#define XB_XCNT(j)  (256  + 64 * (j))
#define XB_XSUB(j)  (1280 + 64 * (j))
#define XB_XGEN(j)  (2304 + 64 * (j))
#define XB_TOP      3328
#define XB_TOPGEN   3392
#define XCD_BAR_WORDS 3456
#define XB_SPIN_CAP (1u << 18)
__device__ __forceinline__ unsigned xb_ld(unsigned* p)              { return __hip_atomic_load(p, __ATOMIC_RELAXED, __HIP_MEMORY_SCOPE_AGENT); }
__device__ __forceinline__ unsigned xb_add(unsigned* p, unsigned v) { return __hip_atomic_fetch_add(p, v, __ATOMIC_RELAXED, __HIP_MEMORY_SCOPE_AGENT); }
__device__ __forceinline__ unsigned xb_xcc_id() { return (unsigned)__builtin_amdgcn_s_getreg((3 << 11) | 20) & 0xFu; }
#define XB_SPIN(cond, bar) do { unsigned _sp = 0; while (cond) { __builtin_amdgcn_s_sleep(1); \
    if ((++_sp & 255u) == 0u) { if (xb_ld(&(bar)[XB_TMO])) break; if (_sp > XB_SPIN_CAP) { atomicAdd(&(bar)[XB_TMO], 1u); break; } } } } while (0)
struct XcdBarrier { unsigned* bar; unsigned x; volatile LAS unsigned* st; };
__device__ __forceinline__ XcdBarrier xcd_barrier_post(unsigned* bar, volatile LAS unsigned* st) {
    XcdBarrier b; b.bar = bar; b.x = xb_xcc_id(); b.st = st;
    if (threadIdx.x == 0) (void)xb_add(&bar[XB_XCNT(b.x)], 1u);
    return b;
}
__device__ __forceinline__ void xcd_barrier_complete(unsigned* bar, unsigned x, unsigned& nloc, unsigned& nx) {
    const unsigned G = gridDim.x * gridDim.y * gridDim.z;
    unsigned sum, cnt, mine, sp = 0u;
    for (;;) {
        sum = 0u; cnt = 0u; mine = 0u;
#pragma unroll
        for (unsigned j = 0; j < 16; ++j) { const unsigned c = xb_ld(&bar[XB_XCNT(j)]); sum += c; cnt += (c > 0u) ? 1u : 0u; mine = (j == x) ? c : mine; }
        if (sum == G) break;
        __builtin_amdgcn_s_sleep(1);
        if ((++sp & 255u) == 0u) { if (xb_ld(&bar[XB_TMO])) break; if (sp > XB_SPIN_CAP) { atomicAdd(&bar[XB_TMO], 1u); break; } }
    }
    nloc = mine > 0u ? mine : 1u; nx = cnt > 0u ? cnt : 1u;
}
__device__ __forceinline__ void xcd_barrier(const XcdBarrier& b) {
    asm volatile("s_waitcnt vmcnt(0)" ::: "memory");
    __syncthreads();
    if (threadIdx.x == 0) {
        unsigned* bar = b.bar;
        __builtin_amdgcn_s_waitcnt(0);
        unsigned nloc = b.st[0], nx = b.st[1];
        if (nloc == 0u) { xcd_barrier_complete(bar, b.x, nloc, nx); b.st[0] = nloc; b.st[1] = nx; }
        const unsigned old = xb_add(&bar[XB_XSUB(b.x)], 1u);
        const unsigned gen = old / nloc;
        if (old + 1u == (gen + 1u) * nloc) {
            __builtin_amdgcn_fence(__ATOMIC_RELEASE, "agent");
            asm volatile("s_waitcnt vmcnt(0)" ::: "memory");
            const unsigned og = xb_add(&bar[XB_TOP], 1u);
            const unsigned tg = og / nx;
            if (og + 1u == (tg + 1u) * nx) xb_add(&bar[XB_TOPGEN], 1u);
            else XB_SPIN(xb_ld(&bar[XB_TOPGEN]) == tg, bar);
            __builtin_amdgcn_fence(__ATOMIC_ACQUIRE, "agent");
            xb_add(&bar[XB_XGEN(b.x)], 1u);
            asm volatile("s_waitcnt vmcnt(0)" ::: "memory");
        } else {
            XB_SPIN(xb_ld(&bar[XB_XGEN(b.x)]) == gen, bar);
            __builtin_amdgcn_fence(__ATOMIC_ACQUIRE, "agent");
            asm volatile("s_waitcnt vmcnt(0)" ::: "memory");
        }
    }
    __syncthreads();
}

constexpr int NWAVES = 8;
enum { I_X = 0, I_MEM, I_POS, I_F1N, I_F1GU, I_F1DN, I_MIXN, I_WIN, I_WPOOL, I_PSCALE, I_QLN, I_KVLN, I_WUQ, I_WUKV, I_QNN, I_KNN, I_QRN, I_KRN,
       I_WBP, I_WBM, I_WOUT, I_XNORM, I_MEMN, I_WXQ, I_WXKV, I_XQN, I_XKN, I_WXO, I_F2N, I_F2GU, I_F2DN, N_IN };
struct Params { const float* in[N_IN]; float* out; unsigned char* ws; int ph_lo, ph_hi; };
static_assert(sizeof(Params) == (N_IN + 2) * 8 + 8, "Params has no padding");


__constant__ float c_inv_freq[32] = {
    1.000000000e+00f, 7.498942018e-01f, 5.623413324e-01f, 4.216965139e-01f, 3.162277639e-01f, 2.371373922e-01f, 1.778279394e-01f, 1.333521456e-01f,
    1.000000015e-01f, 7.498941571e-02f, 5.623412877e-02f, 4.216964915e-02f, 3.162277862e-02f, 2.371373586e-02f, 1.778279431e-02f, 1.333521493e-02f,
    9.999999776e-03f, 7.498942316e-03f, 5.623413250e-03f, 4.216964822e-03f, 3.162277862e-03f, 2.371373819e-03f, 1.778279431e-03f, 1.333521446e-03f,
    1.000000047e-03f, 7.498941850e-04f, 5.623413017e-04f, 4.216965463e-04f, 3.162277862e-04f, 2.371373848e-04f, 1.778279402e-04f, 1.333521504e-04f};

#define LDS_WAIT() asm volatile("s_waitcnt lgkmcnt(0)" ::: "memory")
__device__ __forceinline__ void xcd_skew(int us_per_xcc) {
    if (us_per_xcc <= 0) return;
    const unsigned long long ticks = (unsigned long long)(xb_xcc_id() & 7u) * (unsigned)us_per_xcc * 100ull, t0 = __builtin_amdgcn_s_memrealtime();
    while (__builtin_amdgcn_s_memrealtime() - t0 < ticks) __builtin_amdgcn_s_sleep(4);
}
__device__ __forceinline__ float wave_sum(float v) {
#pragma unroll
    for (int o = 1; o < 64; o <<= 1) v += __shfl_xor(v, o);
    return v;
}
__device__ __forceinline__ unsigned f2bf(float f) { unsigned u = __builtin_bit_cast(unsigned, f); return (u + 0x7fffu + ((u >> 16) & 1u)) >> 16; }
__device__ __forceinline__ unsigned pk2(float lo, float hi) { return f2bf(lo) | (f2bf(hi) << 16); }

template <int MAP> __device__ __forceinline__ int dst_row_of(int n0) {
    if (MAP == 1) { const int isu = n0 >= FF, j = isu ? n0 - FF : n0; return (j >> 7) * 256 + isu * 128 + (j & 127); }
    if (MAP == 2) { if (n0 < 3584) return n0; if (n0 < 3648) return Z_KR + (n0 - 3584); if (n0 < 7744) return Z_GP + (n0 - 3648); return Z_GM + (n0 - 7744); }
    return n0;
}
template <int MAP> __device__ __forceinline__ void transpose_item(const float* W, int K, int N, bf16_t* WT, LAS float* scr, int item, int lane, const float* kgain = nullptr) {
    const int nblk = N / 64, kb = item / nblk, nb = item % nblk, k0 = 64 * kb, n0 = 64 * nb, d0 = dst_row_of<MAP>(n0);
    const int q = lane >> 4, l15 = lane & 15;
    f32x4 v[16];
#pragma unroll
    for (int i = 0; i < 16; ++i) v[i] = __builtin_nontemporal_load((const f32x4*)(W + (size_t)(k0 + 4 * i + q) * N + n0 + l15 * 4));
#pragma unroll
    for (int i = 0; i < 16; ++i) { const float gk = kgain ? kgain[k0 + 4 * i + q] : 1.f; LAS float* s = scr + (4 * i + q) * 65 + l15 * 4; s[0] = v[i].x * gk; s[1] = v[i].y * gk; s[2] = v[i].z * gk; s[3] = v[i].w * gk; }
    LDS_WAIT(); asm volatile("" ::: "memory");
    const int c = lane & 7;
#pragma unroll
    for (int j = 0; j < 8; ++j) { const int n = (lane >> 3) + 8 * j; const LAS float* s = scr + (8 * c) * 65 + n;
        u32x4 o; o.x = cvt_pk_bf16(s[0 * 65], s[1 * 65]); o.y = cvt_pk_bf16(s[2 * 65], s[3 * 65]); o.z = cvt_pk_bf16(s[4 * 65], s[5 * 65]); o.w = cvt_pk_bf16(s[6 * 65], s[7 * 65]);
        *(GAS u32x4*)(WT + (size_t)(d0 + n) * K + k0 + 8 * c) = o; }
    LDS_WAIT(); asm volatile("" ::: "memory");
}
__device__ __forceinline__ void rms_row_4096(const float* xrow, const float* gain, bf16_t* orow, int lane) {
    const f32x4* xr = (const f32x4*)xrow + lane * 2; const f32x4* gr = (const f32x4*)gain + lane * 2;
    f32x4 v[16]; float s = 0.f;
#pragma unroll
    for (int j = 0; j < 8; ++j) { v[2 * j] = xr[128 * j]; v[2 * j + 1] = xr[128 * j + 1];
        s += (v[2 * j].x * v[2 * j].x + v[2 * j].y * v[2 * j].y) + (v[2 * j].z * v[2 * j].z + v[2 * j].w * v[2 * j].w);
        s += (v[2 * j + 1].x * v[2 * j + 1].x + v[2 * j + 1].y * v[2 * j + 1].y) + (v[2 * j + 1].z * v[2 * j + 1].z + v[2 * j + 1].w * v[2 * j + 1].w); }
    const float rstd = rsqrtf(wave_sum(s) * (1.f / 4096.f) + EPS);
    u32x4* o16 = (u32x4*)orow + lane;
#pragma unroll
    for (int j = 0; j < 8; ++j) { const f32x4 g0 = gr[128 * j], g1 = gr[128 * j + 1]; const f32x4 a = v[2 * j] * rstd * g0, b = v[2 * j + 1] * rstd * g1;
        u32x4 w; w.x = cvt_pk_bf16(a.x, a.y); w.y = cvt_pk_bf16(a.z, a.w); w.z = cvt_pk_bf16(b.x, b.y); w.w = cvt_pk_bf16(b.z, b.w); o16[64 * j] = w; }
}
__device__ __forceinline__ void cvt_row_4096(const float* xrow, bf16_t* orow, int lane) {
    const f32x4* xr = (const f32x4*)xrow + lane * 2; u32x4* o16 = (u32x4*)orow + lane; float s = 0.f;
    f32x4 v[16];
#pragma unroll
    for (int j = 0; j < 8; ++j) { v[2 * j] = __builtin_nontemporal_load(xr + 128 * j); v[2 * j + 1] = __builtin_nontemporal_load(xr + 128 * j + 1); }
#pragma unroll
    for (int j = 0; j < 16; ++j) s += (v[j].x * v[j].x + v[j].y * v[j].y) + (v[j].z * v[j].z + v[j].w * v[j].w);
    s = wave_sum(s); const float rs = rsqrtf(s * (1.f / 4096.f) + 1e-6f);
#pragma unroll
    for (int j = 0; j < 8; ++j) { const f32x4 a = v[2 * j] * rs, b = v[2 * j + 1] * rs; u32x4 w; w.x = cvt_pk_bf16(a.x, a.y); w.y = cvt_pk_bf16(a.z, a.w); w.z = cvt_pk_bf16(b.x, b.y); w.w = cvt_pk_bf16(b.z, b.w); o16[64 * j] = w; }
}

#ifndef WGM_DN
#define WGM_DN 2
#endif
#ifndef SKEW_RMW
#define SKEW_RMW 0
#endif
#ifndef PF_DN
#define PF_DN 0
#endif
#ifndef RP_B
#define RP_B 1
#endif
#ifndef RP_C
#define RP_C 1
#endif
#ifndef PROBE_CLK
#define PROBE_CLK -1
#endif
#ifndef PROBE_MODE
#define PROBE_MODE 0
#endif
#ifndef PROBE_MASK
#define PROBE_MASK 0
#endif
#define PROBE_ON(k) ((PROBE_MODE == 0 && PROBE_CLK == (k)) || (PROBE_MODE == 1 && (((PROBE_MASK) >> (k)) & 1)))
#define PROBE2_ON(k) (PROBE_MODE == 2 && (((PROBE_MASK) >> (k)) & 1))
#define PROBE_T0(k) do { if (PROBE2_ON(k) && blockIdx.x == 0 && threadIdx.x == 0) { volatile LAS unsigned long long* pw_ = (volatile LAS unsigned long long*)(LDSP + LDSCTL_OFF); pw_[4] = 1ull; pw_[5] = __builtin_amdgcn_s_memrealtime(); } \
    if (PROBE_ON(k) && blockIdx.x == 0 && threadIdx.x == 0) { volatile LAS unsigned long long* pw_ = (volatile LAS unsigned long long*)(LDSP + LDSCTL_OFF); pw_[0] = __builtin_amdgcn_s_memtime(); pw_[1] = __builtin_amdgcn_s_memrealtime(); } } while (0)
#define PROBE_T1(k) do { if (PROBE2_ON(k) && blockIdx.x == 0 && threadIdx.x == 0) { volatile LAS unsigned long long* pw_ = (volatile LAS unsigned long long*)(LDSP + LDSCTL_OFF); pw_[4] = 0ull; } \
    if (PROBE_ON(k) && blockIdx.x == 0 && threadIdx.x == 0) { volatile LAS unsigned long long* pw_ = (volatile LAS unsigned long long*)(LDSP + LDSCTL_OFF); pw_[2] += __builtin_amdgcn_s_memtime() - pw_[0]; pw_[3] += __builtin_amdgcn_s_memrealtime() - pw_[1]; } } while (0)
constexpr int N_PHASES = 16;

__global__ void __launch_bounds__(NWAVES * 64, 2) mk_fwd(Params P) {
    extern __shared__ __attribute__((aligned(16))) unsigned char lds_raw[];
#define LDSP ((LAS unsigned char*)lds_raw)
#define WSB (P.ws)
    unsigned* ctl = (unsigned*)(WSB + WS_CTL);
    for (int u = threadIdx.x; u < (LDS_BYTES - LDSCTL_OFF) / 4; u += NWAVES * 64) ((LAS unsigned*)(LDSP + LDSCTL_OFF))[u] = 0u;
    __syncthreads();
#if MK_ONE_LAUNCH
    (void)xcd_barrier_post(ctl + CW_BAR, (volatile LAS unsigned*)(LDSP + MISC_OFF) + 8);
#define GRID_BAR() do { XcdBarrier b_; b_.bar = (unsigned*)(WSB + WS_CTL) + CW_BAR; b_.x = xb_xcc_id(); b_.st = (volatile LAS unsigned*)((LAS unsigned char*)lds_raw + MISC_OFF) + 8; xcd_barrier(b_); } while (0)
    constexpr int lo = 0, hi = N_PHASES;
#else
#define GRID_BAR() do { } while (0)
    const int lo = P.ph_lo, hi = P.ph_hi;
#endif
#ifndef MK_PHASES
#define MK_PHASES 0xffff
#endif
#define IN(k) ((((MK_PHASES) >> (k)) & 1) && lo <= (k) && (k) < hi)
#define SEAM(k) do { if (IN(k) && IN((k) + 1)) GRID_BAR(); } while (0)
#define PHASE_IDS() int tid_ = threadIdx.x; asm volatile("" : "+v"(tid_)); const int lane = tid_ & 63, wave_ = __builtin_amdgcn_readfirstlane(tid_ >> 6); \
    const int G_ = gridDim.x, vcu_ = (G_ % 8 == 0) ? ((int)blockIdx.x % 8) * (G_ / 8) + (int)blockIdx.x / 8 : (int)blockIdx.x, gw = vcu_ * NWAVES + wave_, NGW = G_ * NWAVES; (void)gw; (void)NGW; (void)lane; (void)vcu_; (void)wave_

#define WGU ((bf16_t*)(WSB + WS_WGU))
#define WDN ((bf16_t*)(WSB + WS_WDN))
#define WIN ((bf16_t*)(WSB + WS_WIN))
#define WPOOL ((bf16_t*)(WSB + WS_WPOOL))
#define WUQ ((bf16_t*)(WSB + WS_WUQ))
#define WUKV ((bf16_t*)(WSB + WS_WUKV))
#define WBP ((bf16_t*)(WSB + WS_WBP))
#define WBM ((bf16_t*)(WSB + WS_WBM))
#define WOUT ((bf16_t*)(WSB + WS_WOUT))
#define WXQ ((bf16_t*)(WSB + WS_WXQ))
#define WXKV ((bf16_t*)(WSB + WS_WXKV))
#define WXO ((bf16_t*)(WSB + WS_WXO))
#define XN ((bf16_t*)(WSB + WS_XN))
#define MN ((bf16_t*)(WSB + WS_MN))
#define XKV ((float*)(WSB + WS_XKV))
#define XKB ((bf16_t*)(WSB + WS_XKB))
#define XVB ((bf16_t*)(WSB + WS_XVB))
#define HID ((bf16_t*)(WSB + WS_HID))
#define Z ((bf16_t*)(WSB + WS_Z))
#define CQ ((bf16_t*)(WSB + WS_CQ))
#define CKV ((bf16_t*)(WSB + WS_CKV))
#define KR ((bf16_t*)(WSB + WS_KR))
#define CSTAB ((float*)(WSB + WS_CS))
#define GQ8 ((unsigned char*)(WSB + WS_GQ))
#define PM ((bf16_t*)(WSB + WS_PM))
#define QB ((bf16_t*)(WSB + WS_Q))
#define KVB ((bf16_t*)(WSB + WS_KV))
#define AO ((bf16_t*)(WSB + WS_AO))
#define BO ((bf16_t*)(WSB + WS_BO))
#define MG ((bf16_t*)(WSB + WS_R + 376 * MiB))
#define XQP ((float*)(WSB + WS_XQP))
#define XO ((bf16_t*)(WSB + WS_XO))
#define SS0 ((float*)(WSB + WS_SS))
#define SS1 ((float*)(WSB + WS_SS) + M)
#define SS2 ((float*)(WSB + WS_SS) + 2 * M)
#define SSX ((float*)(WSB + WS_SS) + 3 * M)
#define OUT (P.out)

#define TRANSPOSE_JOB(MAP, SRC, KK, NN, DST, KG) { const int nit = ((KK) / 64) * ((NN) / 64); if (r < nit) { transpose_item<MAP>((SRC), (KK), (NN), (DST), scr, r, lane, (KG)); continue; } r -= nit; }

#if RP_C > 1
    for (int rep_ = 0; rep_ < RP_C; ++rep_) { if (rep_) GRID_BAR();
#endif
    PROBE_T0(0);
    if (IN(0)) {
        PHASE_IDS();
        LAS float* scr = (LAS float*)(LDSP + wave_ * 16896);
        constexpr int TOT = (D / 64) * (2 * FF / 64) + (FF / 64) * (D / 64) + (D / 64) * (11840 / 64) + (2048 / 64) * (512 / 64) + (1024 / 64) * (3072 / 64) + (512 / 64) * (4096 / 64)
                          + 2 * (2048 / 64) * (4096 / 64) + (4096 / 64) * (4096 / 64) + (4096 / 64) * (512 / 64) + (4096 / 64) * (1024 / 64) + (512 / 64) * (4096 / 64);
        for (int it = gw; it < TOT; it += NGW) {
            int r = it;
            TRANSPOSE_JOB(1, P.in[I_F1GU], D, 2 * FF, WGU, P.in[I_F1N])
            TRANSPOSE_JOB(0, P.in[I_F1DN], FF, D, WDN, nullptr)
            TRANSPOSE_JOB(2, P.in[I_WIN], D, 11840, WIN, P.in[I_MIXN])
            TRANSPOSE_JOB(0, P.in[I_WPOOL], 2048, 512, WPOOL, nullptr)
            TRANSPOSE_JOB(0, P.in[I_WUQ], 1024, 3072, WUQ, nullptr)
            TRANSPOSE_JOB(0, P.in[I_WUKV], 512, 4096, WUKV, nullptr)
            TRANSPOSE_JOB(0, P.in[I_WBP], 2048, 4096, WBP, nullptr)
            TRANSPOSE_JOB(0, P.in[I_WBM], 2048, 4096, WBM, nullptr)
            TRANSPOSE_JOB(0, P.in[I_WOUT], 4096, 4096, WOUT, nullptr)
            TRANSPOSE_JOB(0, P.in[I_WXQ], 4096, 512, WXQ, P.in[I_XNORM])
            TRANSPOSE_JOB(0, P.in[I_WXKV], 4096, 1024, WXKV, nullptr)
            TRANSPOSE_JOB(0, P.in[I_WXO], 512, 4096, WXO, nullptr)
        }
        { u32x4* zp = (u32x4*)(WIN + (size_t)11840 * D); const int n16 = 192 * D * 2 / 16; for (int i = gw * 64 + lane; i < n16; i += NGW * 64) zp[i] = (u32x4){0u, 0u, 0u, 0u}; }
        for (int m = gw; m < M; m += NGW) cvt_row_4096(P.in[I_X] + (size_t)m * D, XN + (size_t)m * D, lane);
        for (int m = gw; m < MMEM; m += NGW) rms_row_4096(P.in[I_MEM] + (size_t)m * D, P.in[I_MEMN], MN + (size_t)m * D, lane);
    }
#if RP_C > 1
    }
#endif
    PROBE_T1(0);
    SEAM(0);
#if RP_A > 1
    for (int rep_ = 0; rep_ < RP_A; ++rep_) { if (rep_) GRID_BAR();
#else
    constexpr int rep_ = 0;
#endif
    PROBE_T0(1);
    if (IN(1)) {
        pg8::Gemm g = pg8::mk_gemm(XN, WGU, D, D, D); pg8::StaticOrder S; S.init(M / 256, FF / 128, (int)gridDim.x, (int)blockIdx.x);
        pg8::EpiSwiGLU<false> E{HID, FF, nullptr};
        pg8::gemm_phase(LDSP, g, S, E);
    }
    PROBE_T1(1);
    SEAM(1);
    PROBE_T0(2);
    if (IN(2)) {
        xcd_skew(SKEW_RMW); pg8::Gemm g = pg8::mk_gemm(HID, WDN, FF, FF, FF); pg8::StaticOrder S; S.init(M / 256, D / 256, (int)gridDim.x, (int)blockIdx.x, WGM_DN);
        pg8::EpiResH<0> E{P.in[I_X], XN, nullptr, D, 0.5f, SS0};
        pg8::gemm_phase<pg8::EpiResH<0>, pg8::StaticOrder, PF_DN>(LDSP, g, S, E);
    }
#if RP_A > 1
    }
#endif
    PROBE_T1(2);
    SEAM(2);
    PROBE_T0(3);
    if (IN(3)) {
        { pg8::Gemm g = pg8::mk_gemm(XN, WIN, D, D, D); pg8::StaticOrder S; S.init(M / 256, ZW / 256, (int)gridDim.x, (int)blockIdx.x);
          pg8::EpiWin E{Z, ZW, GQ8, (size_t)M * 4096, SS0};
          pg8::gemm_phase(LDSP, g, S, E); }
        { pg8::Gemm g = pg8::mk_gemm(MN, WXKV, D, D, D); pg8::StaticOrder S; S.init(MMEM / 256, 1024 / 256, (int)gridDim.x, (int)((blockIdx.x + 64u) % (unsigned)(int)gridDim.x));
          pg8::EpiF32Split E{XKV, 1024, 0x7fffffff, 30, 0, nullptr};
          pg8::gemm_phase(LDSP, g, S, E); }
    }
    PROBE_T1(3);
    SEAM(3);
#if RP_D > 1
    for (int repd_ = 0; repd_ < RP_D; ++repd_) { if (repd_) GRID_BAR();
#endif
    PROBE_T0(4);
    if (IN(4)) {
        PHASE_IDS();
        const float* gq = P.in[I_QLN]; const float* gkv = P.in[I_KVLN]; const float* gkr = P.in[I_KRN]; const int* pos = (const int*)P.in[I_POS];
        for (int m = gw; m < M; m += NGW) {
            const bf16_t* zr = Z + (size_t)m * ZW; const int t = m & (SEQ - 1);
            const u32x4 zq0 = *(const u32x4*)(zr + Z_ZQ + lane * 8), zq1 = *(const u32x4*)(zr + Z_ZQ + 512 + lane * 8), zkv = *(const u32x4*)(zr + Z_ZKV + lane * 8);
            const unsigned zkr = (unsigned)zr[Z_KR + lane]; const int posm = pos[m];
            u32x4 pown[4], pnb[29];
#pragma unroll
            for (int g = 0; g < 4; ++g) pown[g] = *(const u32x4*)(zr + Z_ZP + g * 512 + lane * 8);
            const bool fullw = t >= 15;
            if (fullw) {
#pragma unroll
                for (int g = 0; g < 4; ++g)
#pragma unroll
                    for (int j = 1; j < (2 << g); ++j) pnb[(2 << g) - 2 + j - 1] = *(const u32x4*)(zr - (size_t)j * ZW + Z_ZP + g * 512 + lane * 8);
            }
            asm volatile("" ::: "memory");
            {
                float a[8], b[8]; unpack8(zq0, a); unpack8(zq1, b);
                float s = 0.f;
#pragma unroll
                for (int e = 0; e < 8; ++e) s += a[e] * a[e] + b[e] * b[e];
                const float rstd = rsqrtf(wave_sum(s) * (1.f / 1024.f) + EPS);
#pragma unroll
                for (int e = 0; e < 8; ++e) { a[e] *= rstd * gq[lane * 8 + e]; b[e] *= rstd * gq[512 + lane * 8 + e]; }
                *(u32x4*)(CQ + (size_t)m * 1024 + lane * 8) = pack8(a); *(u32x4*)(CQ + (size_t)m * 1024 + 512 + lane * 8) = pack8(b); }
            {
                float a[8]; unpack8(zkv, a);
                float s = 0.f;
#pragma unroll
                for (int e = 0; e < 8; ++e) s += a[e] * a[e];
                const float rstd = rsqrtf(wave_sum(s) * (1.f / 512.f) + EPS);
#pragma unroll
                for (int e = 0; e < 8; ++e) a[e] *= rstd * gkv[lane * 8 + e];
                *(u32x4*)(CKV + (size_t)m * 512 + lane * 8) = pack8(a); }
            {
                const float x = bf_lo(zkr);
                const float rstd = rsqrtf(wave_sum(x * x) * (1.f / 64.f) + EPS);
                const float y = x * rstd * gkr[lane], yp = __shfl_xor(y, 32);
                const float ang = (float)posm * c_inv_freq[lane & 31], cs = cosf(ang), sn = sinf(ang);
                const float o = (lane < 32) ? (y * cs - yp * sn) : (y * cs + yp * sn);
                KR[(size_t)m * 64 + lane] = (bf16_t)f2bf(o);
                CSTAB[(size_t)m * 64 + lane] = (lane < 32) ? cs : sn; }
            {
#pragma unroll
                for (int g = 0; g < 4; ++g) { const int w = 2 << g; float acc[8], own[8];
                    unpack8(pown[g], own);
#pragma unroll
                    for (int e = 0; e < 8; ++e) acc[e] = own[e];
                    const int nb = t < (w - 1) ? t : (w - 1);
                    if (fullw) {
#pragma unroll
                        for (int j = 1; j < w; ++j) { float v[8]; unpack8(pnb[w - 2 + j - 1], v);
#pragma unroll
                            for (int e = 0; e < 8; ++e) acc[e] += v[e]; }
                    } else {
                        for (int j = 1; j <= nb; ++j) { float v[8]; unpack8(*(const u32x4*)(zr - (size_t)j * ZW + Z_ZP + g * 512 + lane * 8), v);
#pragma unroll
                            for (int e = 0; e < 8; ++e) acc[e] += v[e]; } }
                    const float inv = 1.0f / (float)(nb + 1);
#pragma unroll
                    for (int e = 0; e < 8; ++e) acc[e] = acc[e] * inv - own[e];
                    *(u32x4*)(PM + (size_t)m * 2048 + g * 512 + lane * 8) = pack8(acc); } }
        }
        {
            const float* gxk = P.in[I_XKN];
            for (int m = gw; m < MMEM; m += NGW) {
                const float* kr = XKV + (size_t)m * 1024 + lane * 8; const float* vr = kr + 512;
                const f32x4 k0 = *(const f32x4*)kr, k1 = *(const f32x4*)(kr + 4), v0 = *(const f32x4*)vr, v1 = *(const f32x4*)(vr + 4);
                float s = (k0.x * k0.x + k0.y * k0.y) + (k0.z * k0.z + k0.w * k0.w) + (k1.x * k1.x + k1.y * k1.y) + (k1.z * k1.z + k1.w * k1.w);
                s += __shfl_xor(s, 1); s += __shfl_xor(s, 2); s += __shfl_xor(s, 4); s += __shfl_xor(s, 8);
                const float rstd = rsqrtf(s * (1.f / 128.f) + EPS); const int c = (lane & 15) * 8;
                float a[8] = {k0.x * rstd * gxk[c], k0.y * rstd * gxk[c + 1], k0.z * rstd * gxk[c + 2], k0.w * rstd * gxk[c + 3], k1.x * rstd * gxk[c + 4], k1.y * rstd * gxk[c + 5], k1.z * rstd * gxk[c + 6], k1.w * rstd * gxk[c + 7]};
                float bb[8] = {v0.x, v0.y, v0.z, v0.w, v1.x, v1.y, v1.z, v1.w};
                *(u32x4*)(XKB + (size_t)m * 512 + lane * 8) = pack8(a); *(u32x4*)(XVB + (size_t)m * 512 + lane * 8) = pack8(bb);
            } }
        {
            LAS float* scr = (LAS float*)(LDSP + wave_ * 16896);
            constexpr int TOT = (D / 64) * (2 * FF / 64) + (FF / 64) * (D / 64);
            for (int it = gw; it < TOT; it += NGW) {
                int r = it;
                TRANSPOSE_JOB(1, P.in[I_F2GU], D, 2 * FF, WGU, P.in[I_F2N])
                TRANSPOSE_JOB(0, P.in[I_F2DN], FF, D, WDN, nullptr)
            } }
    }
#if RP_D > 1
    }
#endif
    PROBE_T1(4);
    SEAM(4);
    PROBE_T0(5);
    if (IN(5)) {
        { pg8::Gemm g = pg8::mk_gemm(CQ, WUQ, 1024, 1024, 1024); pg8::StaticOrder S; S.init(M / 256, QW / 256, (int)gridDim.x, (int)blockIdx.x);
          pg8::EpiBf16S<false> E{QB, QW, nullptr}; pg8::gemm_phase(LDSP, g, S, E); }
        { pg8::Gemm g = pg8::mk_gemm(CKV, WUKV, 512, 512, 512); pg8::StaticOrder S; S.init(M / 256, KVW / 256, (int)gridDim.x, (int)blockIdx.x);
          pg8::EpiKV E{KVB, KVW, P.in[I_KNN], (LAS float*)(LDSP + RING_BYTES)}; pg8::gemm_phase(LDSP, g, S, E); }
        { pg8::Gemm g = pg8::mk_gemm(PM, WPOOL, 2048, 2048, 512); g.ashift = 1; g.astride = 512; g.bmask = 1; g.bstride = 512;
          pg8::StaticOrder S; S.init(M / 256, AW / 256, (int)gridDim.x, (int)blockIdx.x);
          pg8::EpiBf16S<true> E{AO, AW, P.in[I_PSCALE]}; pg8::gemm_phase(LDSP, g, S, E); }
    }
    PROBE_T1(5);
    SEAM(5);
    PROBE_T0(6);
    PROBE_T1(6);
#if RP_B > 1
    for (int rep_ = 0; rep_ < RP_B; ++rep_) { if (rep_) GRID_BAR();
#endif
    PROBE_T0(7);
    if (IN(7)) {
        PHASE_IDS();
        const int r32 = lane & 31, hi5 = lane >> 5;
        for (int item = vcu_; item < 512; item += (int)gridDim.x) {
            const int bh = item >> 4, x = item & 15, b = bh >> 4, h = bh & 15;
#pragma unroll 1
            for (int half = 0; half < 2; ++half) {
                const int qb = half ? x : 31 - x;
                const size_t row0 = (size_t)b * SEQ + (size_t)qb * 256;
                bf16x8 qr[12];
                int t3 = threadIdx.x; asm volatile("" : "+v"(t3));
                { const int hq = (t3 >> 5) & 1; const size_t qrow = row0 + (t3 >> 6) * 32 + (t3 & 31);
                  const bf16_t* Qw = QB + qrow * QW + h * 192 + hq * 8;
                  float x[12][8]; float sn_ = 0.f, sr_ = 0.f;
#pragma unroll
                  for (int d0 = 0; d0 < 12; ++d0) { unpack8(*(const u32x4*)(Qw + d0 * 16), x[d0]);
#pragma unroll
                      for (int j = 0; j < 8; ++j) { if (d0 < 8) sn_ += x[d0][j] * x[d0][j]; else sr_ += x[d0][j] * x[d0][j]; } }
                  sn_ = xsum32(sn_); sr_ = xsum32(sr_);
                  const float rn = rsqrtf(sn_ * (1.f / 128.f) + EPS) * QSCALE, rr = rsqrtf(sr_ * (1.f / 64.f) + EPS);
                  const float* gqn = P.in[I_QNN] + hq * 8; const float* gqr = P.in[I_QRN] + hq * 8; const float* cst = CSTAB + qrow * 64 + hq * 8;
#pragma unroll
                  for (int d0 = 0; d0 < 8; ++d0) { const f32x4 g0 = *(const f32x4*)(gqn + d0 * 16), g1 = *(const f32x4*)(gqn + d0 * 16 + 4);
                      float y[8] = {x[d0][0] * rn * g0.x, x[d0][1] * rn * g0.y, x[d0][2] * rn * g0.z, x[d0][3] * rn * g0.w, x[d0][4] * rn * g1.x, x[d0][5] * rn * g1.y, x[d0][6] * rn * g1.z, x[d0][7] * rn * g1.w};
                      qr[d0] = __builtin_bit_cast(bf16x8, pack8(y)); }
#pragma unroll
                  for (int dd = 0; dd < 2; ++dd) {
                      const f32x4 ga0 = *(const f32x4*)(gqr + dd * 16), ga1 = *(const f32x4*)(gqr + dd * 16 + 4), gb0 = *(const f32x4*)(gqr + 32 + dd * 16), gb1 = *(const f32x4*)(gqr + 32 + dd * 16 + 4);
                      const f32x4 c0 = *(const f32x4*)(cst + dd * 16), c1 = *(const f32x4*)(cst + dd * 16 + 4), s0 = *(const f32x4*)(cst + 32 + dd * 16), s1 = *(const f32x4*)(cst + 32 + dd * 16 + 4);
                      const float ga[8] = {ga0.x, ga0.y, ga0.z, ga0.w, ga1.x, ga1.y, ga1.z, ga1.w}, gb[8] = {gb0.x, gb0.y, gb0.z, gb0.w, gb1.x, gb1.y, gb1.z, gb1.w};
                      const float cc[8] = {c0.x, c0.y, c0.z, c0.w, c1.x, c1.y, c1.z, c1.w}, ss[8] = {s0.x, s0.y, s0.z, s0.w, s1.x, s1.y, s1.z, s1.w};
                      float ya[8], yb[8];
#pragma unroll
                      for (int j = 0; j < 8; ++j) { const float a = x[8 + dd][j] * rr * ga[j], bq = x[10 + dd][j] * rr * gb[j];
                          ya[j] = (a * cc[j] - bq * ss[j]) * QSCALE; yb[j] = (bq * cc[j] + a * ss[j]) * QSCALE; }
                      qr[8 + dd] = __builtin_bit_cast(bf16x8, pack8(ya)); qr[10 + dd] = __builtin_bit_cast(bf16x8, pack8(yb)); } }
                att::attn_unit_pp<192, true>(qr, KVB + (size_t)b * SEQ * KVW + h * 256, KVW, KR + (size_t)b * SEQ * 64, 64, KVB + (size_t)b * SEQ * KVW + h * 256 + 128, KVW,
                                          BO + row0 * AW + h * 128, AW, 4 * (qb + 1), (char*)lds_raw);
            }
        }
    }
#if RP_B > 1
    }
#endif
    PROBE_T1(7);
    SEAM(7);
    PROBE_T0(8);
    PROBE_T1(8);
    PROBE_T0(9);
    if (IN(9)) {
        pg8::Gemm g = pg8::mk_gemm(AO, WBP, AW, AW, AW); g.A2 = BO; g.Bt2 = WBM;
        pg8::TwoSegOrder S; S.init(M / 256, D / 256, (int)gridDim.x, (int)blockIdx.x);
        pg8::EpiMerge2 E{MG, D, GQ8, (size_t)M * 4096}; pg8::gemm_phase(LDSP, g, S, E);
    }
    PROBE_T1(9);
    SEAM(9);
    PROBE_T0(10);
    if (IN(10)) {
        xcd_skew(SKEW_RMW); pg8::Gemm g = pg8::mk_gemm(MG, WOUT, D, D, D); pg8::StaticOrder S; S.init(M / 256, D / 256, (int)gridDim.x, (int)blockIdx.x);
        pg8::EpiResH<1> E{nullptr, XN, nullptr, D, 1.0f, SS1}; pg8::gemm_phase(LDSP, g, S, E);
    }
    PROBE_T1(10);
    SEAM(10);
    PROBE_T0(11);
    if (IN(11)) {
        pg8::Gemm g = pg8::mk_gemm(XN, WXQ, D, D, 2048); g.ashift = 1; g.astride = 2048; g.bmask = 1; g.bstride = 2048;
        pg8::StaticOrder S; S.init(M / 256, 4, (int)gridDim.x, (int)blockIdx.x);
        pg8::EpiF32Split E{XQP, 512, 1, 1, (size_t)M * 512, SS1}; pg8::gemm_phase(LDSP, g, S, E);
    }
    PROBE_T1(11);
    SEAM(11);
    PROBE_T0(12);
    if (IN(12)) {
        PHASE_IDS();
        const int r32 = lane & 31, hi5 = lane >> 5; const float* gxq = P.in[I_XQN];
        for (int item = vcu_; item < 256; item += (int)gridDim.x) {
            const int bh = item >> 5, qb = item & 31, b = bh >> 2, h = bh & 3;
            const size_t row0 = (size_t)b * SEQ + (size_t)qb * 256;
            bf16x8 qr[8];
            { const float* q0 = XQP + (row0 + wave_ * 32 + r32) * 512 + h * 128 + hi5 * 8; const float* q1 = q0 + (size_t)M * 512;
              f32x4 qa[8], qbv[8]; float s = 0.f;
#pragma unroll
              for (int d0 = 0; d0 < 8; ++d0) { qa[d0] = *(const f32x4*)(q0 + d0 * 16) + *(const f32x4*)(q1 + d0 * 16); qbv[d0] = *(const f32x4*)(q0 + d0 * 16 + 4) + *(const f32x4*)(q1 + d0 * 16 + 4);
                  s += (qa[d0].x * qa[d0].x + qa[d0].y * qa[d0].y) + (qa[d0].z * qa[d0].z + qa[d0].w * qa[d0].w) + (qbv[d0].x * qbv[d0].x + qbv[d0].y * qbv[d0].y) + (qbv[d0].z * qbv[d0].z + qbv[d0].w * qbv[d0].w); }
              s = xsum32(s);
              const float rstd = rsqrtf(s * (1.f / 128.f) + EPS) * XSCALE;
#pragma unroll
              for (int d0 = 0; d0 < 8; ++d0) { const float* gp = gxq + d0 * 16 + hi5 * 8; const f32x4 g0 = *(const f32x4*)gp, g1 = *(const f32x4*)(gp + 4);
                  const f32x4 a = qa[d0] * rstd * g0, c = qbv[d0] * rstd * g1; u32x4 w; w.x = cvt_pk_bf16(a.x, a.y); w.y = cvt_pk_bf16(a.z, a.w); w.z = cvt_pk_bf16(c.x, c.y); w.w = cvt_pk_bf16(c.z, c.w);
                  qr[d0] = __builtin_bit_cast(bf16x8, w); } }
            att::attn_unit<128, false>(qr, XKB + (size_t)b * 256 * 512 + h * 128, 512, nullptr, 0, XVB + (size_t)b * 256 * 512 + h * 128, 512,
                                       XO + row0 * 512 + h * 128, 512, 4, (char*)lds_raw);
        }
    }
    PROBE_T1(12);
    SEAM(12);
    PROBE_T0(13);
    if (IN(13)) {
        xcd_skew(SKEW_RMW); pg8::Gemm g = pg8::mk_gemm(XO, WXO, 512, 512, 512); pg8::StaticOrder S; S.init(M / 256, D / 256, (int)gridDim.x, (int)blockIdx.x);
        pg8::EpiResH<1> E{nullptr, XN, nullptr, D, 1.0f, SS2}; pg8::gemm_phase(LDSP, g, S, E);
    }
    PROBE_T1(13);
    SEAM(13);
    PROBE_T0(14);
    if (IN(14)) {
        pg8::Gemm g = pg8::mk_gemm(XN, WGU, D, D, D); pg8::StaticOrder S; S.init(M / 256, FF / 128, (int)gridDim.x, (int)blockIdx.x);
        pg8::EpiSwiGLU<true> E{HID, FF, SS2}; pg8::gemm_phase(LDSP, g, S, E);
    }
    PROBE_T1(14);
    SEAM(14);
    PROBE_T0(15);
    if (IN(15)) {
        xcd_skew(SKEW_RMW); pg8::Gemm g = pg8::mk_gemm(HID, WDN, FF, FF, FF); pg8::StaticOrder S; S.init(M / 256, D / 256, (int)gridDim.x, (int)blockIdx.x, WGM_DN);
        pg8::EpiResH<2> E{nullptr, XN, OUT, D, 0.5f, nullptr}; pg8::gemm_phase<pg8::EpiResH<2>, pg8::StaticOrder, PF_DN>(LDSP, g, S, E);
    }
    PROBE_T1(15);
    if ((PROBE_CLK >= 0 || PROBE_MODE >= 1) && blockIdx.x == 0 && threadIdx.x == 0) {
        volatile LAS unsigned long long* pw_ = (volatile LAS unsigned long long*)(LDSP + LDSCTL_OFF);
        const unsigned long long dc = pw_[2], dr = pw_[3];
        const unsigned long long ticks = PROBE_MODE ? dr : (dc * 5000ull) / (dr ? dr : 1ull);
        const unsigned long long t0 = __builtin_amdgcn_s_memrealtime();
        while (__builtin_amdgcn_s_memrealtime() - t0 < ticks) __builtin_amdgcn_s_sleep(8);
    }
#undef IN
#undef SEAM
#undef TRANSPOSE_JOB
}

extern "C" void kernel_launch(void* const* d_in, const int* in_sizes, int n_in, void* d_out, int out_size, void* d_ws, size_t ws_size, hipStream_t stream) {
    static int grid = 0;
    if (grid == 0) {
        if (n_in != N_IN || in_sizes[0] != M * D || out_size != M * D || ws_size < WS_END) {
            fprintf(stderr, "kernel_launch: unexpected shapes: n_in %d in0 %d out %d ws %zu (need %zu)\n", n_in, n_in > 0 ? in_sizes[0] : -1, out_size, ws_size, (size_t)WS_END); grid = -1; return; }
        int dev = 0, cus = 0;
        if (hipGetDevice(&dev) != hipSuccess || hipDeviceGetAttribute(&cus, hipDeviceAttributeMultiprocessorCount, dev) != hipSuccess) { grid = -1; return; }
        if (hipFuncSetAttribute((const void*)mk_fwd, hipFuncAttributeMaxDynamicSharedMemorySize, LDS_BYTES) != hipSuccess) { fprintf(stderr, "kernel_launch: hipFuncSetAttribute failed\n"); grid = -1; return; }
        int per_cu = 0;
        if (hipOccupancyMaxActiveBlocksPerMultiprocessor(&per_cu, (const void*)mk_fwd, NWAVES * 64, LDS_BYTES) != hipSuccess || per_cu < 1) { fprintf(stderr, "kernel_launch: occupancy query says %d\n", per_cu); }
        (void)hipGetLastError();
        grid = cus;
    }
    if (grid < 0) return;
    (void)hipMemsetAsync((char*)d_ws + WS_CTL, 0, CTL_ZERO_BYTES, stream);
    Params p{};
    for (int i = 0; i < N_IN; ++i) p.in[i] = (const float*)d_in[i];
    p.out = (float*)d_out; p.ws = (unsigned char*)d_ws;
#if MK_ONE_LAUNCH
    p.ph_lo = 0; p.ph_hi = N_PHASES;
    hipLaunchKernelGGL(mk_fwd, dim3(grid), dim3(NWAVES * 64), LDS_BYTES, stream, p);
#else
    for (int k = 0; k < N_PHASES; ++k) { p.ph_lo = k; p.ph_hi = k + 1; hipLaunchKernelGGL(mk_fwd, dim3(grid), dim3(NWAVES * 64), LDS_BYTES, stream, p); }
#endif
    const hipError_t le = hipPeekAtLastError();
    if (le != hipSuccess) fprintf(stderr, "kernel_launch: launch failed: %s\n", hipGetErrorName(le));
}
```

```cpp
#include <hip/hip_runtime.h>
#include <cstdio>
#include <cstdint>

#ifndef MK_ONE_LAUNCH
#define MK_ONE_LAUNCH 1
#endif
#ifndef PROBE_MODE
#define PROBE_MODE 0
#endif

#define LAS __attribute__((address_space(3)))
#define GAS __attribute__((address_space(1)))
typedef unsigned short bf16_t;
typedef short bf16x8 __attribute__((ext_vector_type(8)));
typedef short s16x4 __attribute__((ext_vector_type(4)));
typedef float f32x2 __attribute__((ext_vector_type(2)));
typedef float f32x4 __attribute__((ext_vector_type(4)));
typedef float f32x16 __attribute__((ext_vector_type(16)));
typedef unsigned u32x2 __attribute__((ext_vector_type(2)));
typedef unsigned u32x4 __attribute__((ext_vector_type(4)));

constexpr int D = 4096, SEQ = 8192, M = 16384, MMEM = 512, FF = 11008;
constexpr int ZW = 12032;
constexpr int Z_ZP = 0, Z_ZQ = 2048, Z_ZKV = 3072, Z_GP = 3584, Z_GM = 7680, Z_KR = 11776;
constexpr int NH = 16, QW = 3072, KVW = 4096, AW = 2048;
constexpr float EPS = 1e-6f;
constexpr float LOG2E = 1.4426950408889634f;
constexpr float QSCALE = 0.07216878364870323f * LOG2E;
constexpr float XSCALE = 0.08838834764831845f * LOG2E;

constexpr size_t MiB = 1u << 20;
constexpr size_t WS_CTL = 0, CTL_ZERO_BYTES = 1 * MiB;
constexpr size_t WS_WGU = 1 * MiB, WS_WDN = 173 * MiB, WS_WIN = 259 * MiB, WS_WPOOL = 353 * MiB, WS_WUQ = 355 * MiB, WS_WUKV = 361 * MiB,
                 WS_WBP = 365 * MiB, WS_WBM = 381 * MiB, WS_WOUT = 397 * MiB, WS_WXQ = 429 * MiB, WS_WXKV = 433 * MiB, WS_WXO = 441 * MiB;
constexpr size_t WS_XN = 445 * MiB, WS_MN = 573 * MiB, WS_XKV = 577 * MiB, WS_XKB = 579 * MiB, WS_XVB = 579 * MiB + 512 * 1024;
constexpr size_t WS_R = 580 * MiB;
constexpr size_t WS_HID = WS_R, WS_Z = WS_R, WS_CQ = WS_R + 376 * MiB, WS_CKV = WS_R + 408 * MiB, WS_KR = WS_R + 424 * MiB, WS_PM = WS_R + 426 * MiB,
                 WS_Q = WS_R + 490 * MiB, WS_KV = WS_R + 586 * MiB, WS_AO = WS_R + 714 * MiB, WS_BO = WS_R + 778 * MiB, WS_CS = WS_R + 842 * MiB, WS_GQ = WS_R + 846 * MiB, WS_END = WS_R + 974 * MiB;
constexpr size_t WS_XQP = WS_R, WS_XO = WS_R + 64 * MiB, WS_UQ = WS_R + 80 * MiB;
constexpr size_t WS_SS = 64 * 1024;
constexpr int CW_BAR = 4096;

constexpr int RING_BYTES = 131072, LDSCTL_OFF = 135168, MISC_OFF = LDSCTL_OFF + 320, LDS_BYTES = 147456;

__device__ __forceinline__ unsigned cvt_pk_bf16(float lo, float hi) { unsigned r; asm volatile("v_cvt_pk_bf16_f32 %0, %1, %2" : "=v"(r) : "v"(lo), "v"(hi)); return r; }
__device__ __forceinline__ float bf_lo(unsigned u) { return __builtin_bit_cast(float, u << 16); }
__device__ __forceinline__ float bf_hi(unsigned u) { return __builtin_bit_cast(float, u & 0xffff0000u); }
__device__ __forceinline__ void unpack8(const u32x4 v, float (&f)[8]) { f[0] = bf_lo(v.x); f[1] = bf_hi(v.x); f[2] = bf_lo(v.y); f[3] = bf_hi(v.y); f[4] = bf_lo(v.z); f[5] = bf_hi(v.z); f[6] = bf_lo(v.w); f[7] = bf_hi(v.w); }
__device__ __forceinline__ u32x4 pack8(const float (&f)[8]) { u32x4 w; w.x = cvt_pk_bf16(f[0], f[1]); w.y = cvt_pk_bf16(f[2], f[3]); w.z = cvt_pk_bf16(f[4], f[5]); w.w = cvt_pk_bf16(f[6], f[7]); return w; }
__device__ __forceinline__ float xsum16(float s) { auto r = __builtin_amdgcn_permlane16_swap(__float_as_uint(s), __float_as_uint(s), false, false); return __uint_as_float(r[0]) + __uint_as_float(r[1]); }
__device__ __forceinline__ float xsum32(float s) { auto r = __builtin_amdgcn_permlane32_swap(__float_as_uint(s), __float_as_uint(s), false, false); return __uint_as_float(r[0]) + __uint_as_float(r[1]); }
typedef short s16x2_t __attribute__((ext_vector_type(2)));
__device__ __forceinline__ float sq2bf(unsigned w, float c) { const s16x2_t a = __builtin_bit_cast(s16x2_t, w); return __builtin_amdgcn_fdot2_f32_bf16(a, a, c, false); }
__device__ __forceinline__ float sigmoidf_(float x) { return __builtin_amdgcn_rcpf(1.0f + __builtin_amdgcn_exp2f(-x * LOG2E)); }

namespace pg8 {
constexpr int BM = 256, BK = 64, HALF = 128, HTB = HALF * BK * 2, STAGE_BYTES = 8 * HTB, NXCD = 8, WGM = 8;
__host__ __device__ __forceinline__ int lds_byte(int r, int c) { const int st = (r >> 4) * 2 + (c >> 5), rr = r & 15, cc = c & 31, ob = rr * 64 + cc * 2; return st * 1024 + (ob ^ (((ob >> 9) & 1) << 5)); }
__host__ __device__ __forceinline__ void stage_rc(int b, int& R, int& C) { const int st = b / 1024, sb = b % 1024, swz = sb ^ (((sb >> 9) & 1) << 5); R = (st >> 1) * 16 + swz / 64; C = (st & 1) * 32 + (swz % 64) / 2; }
__host__ __device__ __forceinline__ int perm32(int rho) { const int n = rho >> 4, i = rho & 15; return 8 * (i >> 2) + 4 * n + (i & 3); }

struct Unit { int pm, pn, seg; };
struct Gemm { const bf16_t* A; const bf16_t* Bt; int lda, ldb, K; int ashift, astride, bmask, bstride; const bf16_t* A2; const bf16_t* Bt2; };
__device__ __forceinline__ Gemm mk_gemm(const bf16_t* A, const bf16_t* Bt, int lda, int ldb, int K) { Gemm g; g.A = A; g.Bt = Bt; g.lda = lda; g.ldb = ldb; g.K = K; g.ashift = 30; g.astride = 0; g.bmask = 0x7fffffff; g.bstride = 0; g.A2 = A; g.Bt2 = Bt; return g; }

struct StaticOrder {
    int nM, nN, nwg, G, c, wgm;
    __host__ __device__ void init(int nM_, int nN_, int G_, int c_, int wgm_ = WGM) { nM = nM_; nN = nN_; nwg = nM * nN; G = G_; c = c_; wgm = wgm_; }
    __host__ __device__ bool next(int i, Unit& u) const {
        const long L = (long)i * G + c; if (L >= nwg) return false;
        int wgid = (int)L; { const int q = nwg / NXCD, r = nwg % NXCD, xcd = wgid % NXCD, off = wgid / NXCD; wgid = (xcd < r ? xcd * (q + 1) : r * (q + 1) + (xcd - r) * q) + off; }
        const int nig = wgm * nN, gid = wgid / nig, fm = gid * wgm, gsz = (nM - fm) < wgm ? (nM - fm) : wgm;
        u.pm = fm + ((wgid % nig) % gsz); u.pn = (wgid % nig) / gsz; u.seg = 0; return true;
    }
};
struct TwoSegOrder : StaticOrder {
    __host__ __device__ bool next(int i, Unit& u) const { if (!StaticOrder::next(i >> 1, u)) return false; u.seg = i & 1; return true; }
};

__device__ __forceinline__ float row_rstd(const float* rowss, int row) { return rowss ? rsqrtf(rowss[row] * (1.f / 4096.f) + 1e-6f) : 1.f; }
template <bool ROWSCALE> struct EpiSwiGLU {
    static constexpr bool TWOSEG = false; static constexpr bool PERM = true;
    bf16_t* H; int ldh; const float* rowss;
    __device__ __forceinline__ void operator()(const f32x4 (&acc)[2][2][4][2], const Unit& u, int wr, int wc, int fr, int fq) const {
        const int row0 = u.pm * BM + wr * 64 + fr, col0 = u.pn * HALF + wc * 32 + 8 * fq;
#pragma unroll
        for (int ai = 0; ai < 2; ++ai)
#pragma unroll
            for (int m = 0; m < 4; ++m) {
                const int row = row0 + ai * HALF + m * 16; const float rs = ROWSCALE ? row_rstd(rowss, row) : 1.f, rse = -rs * LOG2E, rsq = rs * rs;
                f32x4 hv[2];
#pragma unroll
                for (int n = 0; n < 2; ++n) { const f32x4 g = acc[ai][0][m][n], t = g * rse; f32x4 d;
#pragma unroll
                    for (int e = 0; e < 4; ++e) d[e] = __builtin_amdgcn_exp2f(t[e]);
                    d = d + 1.0f;
#pragma unroll
                    for (int e = 0; e < 4; ++e) d[e] = __builtin_amdgcn_rcpf(d[e]);
                    hv[n] = (g * acc[ai][1][m][n]) * d; if (ROWSCALE) hv[n] = hv[n] * rsq; }
                u32x4 w; w.x = cvt_pk_bf16(hv[0][0], hv[0][1]); w.y = cvt_pk_bf16(hv[0][2], hv[0][3]); w.z = cvt_pk_bf16(hv[1][0], hv[1][1]); w.w = cvt_pk_bf16(hv[1][2], hv[1][3]);
                *(u32x4*)(H + (size_t)row * ldh + col0) = w; }
    }
};
template <int MODE> struct EpiResH {
    static constexpr bool TWOSEG = false; static constexpr bool PERM = true;
    const float* xf; bf16_t* H; float* outf; int ldc; float alpha; float* rowss;
    __device__ __forceinline__ void operator()(const f32x4 (&acc)[2][2][4][2], const Unit& u, int wr, int wc, int fr, int fq) const {
        const int row0 = u.pm * BM + wr * 64 + fr, col0 = u.pn * BM + wc * 32 + 8 * fq;
#pragma unroll
        for (int ai = 0; ai < 2; ++ai) {
            f32x4 b0[4][2], b1[4][2];
#pragma unroll
            for (int m = 0; m < 4; ++m)
#pragma unroll
                for (int bj = 0; bj < 2; ++bj) { const size_t off = (size_t)(row0 + ai * HALF + m * 16) * ldc + col0 + bj * HALF;
                    if (MODE == 0) { b0[m][bj] = *(const f32x4*)(xf + off); b1[m][bj] = *(const f32x4*)(xf + off + 4); }
                    else { const u32x4 hv = *(const u32x4*)(H + off); b0[m][bj] = (f32x4){bf_lo(hv.x), bf_hi(hv.x), bf_lo(hv.y), bf_hi(hv.y)}; b1[m][bj] = (f32x4){bf_lo(hv.z), bf_hi(hv.z), bf_lo(hv.w), bf_hi(hv.w)}; } }
            asm volatile("" ::: "memory");
#pragma unroll
            for (int m = 0; m < 4; ++m) { const int row = row0 + ai * HALF + m * 16; float s = 0.f;
#pragma unroll
                for (int bj = 0; bj < 2; ++bj) { const size_t off = (size_t)row * ldc + col0 + bj * HALF;
                    const f32x4 al4 = {alpha, alpha, alpha, alpha}; const f32x4 h0 = __builtin_elementwise_fma(acc[ai][bj][m][0], al4, b0[m][bj]), h1 = __builtin_elementwise_fma(acc[ai][bj][m][1], al4, b1[m][bj]);
                    if (MODE == 2) { *(f32x4*)(outf + off) = h0; *(f32x4*)(outf + off + 4) = h1; }
                    else { u32x4 w; w.x = cvt_pk_bf16(h0.x, h0.y); w.y = cvt_pk_bf16(h0.z, h0.w); w.z = cvt_pk_bf16(h1.x, h1.y); w.w = cvt_pk_bf16(h1.z, h1.w); *(u32x4*)(H + off) = w;
                        s = sq2bf(w.x, sq2bf(w.y, sq2bf(w.z, sq2bf(w.w, s)))); } }
                if (MODE != 2) { s = xsum32(xsum16(s)); if (fq == 0) atomicAdd(rowss + row, s); } }
            asm volatile("" ::: "memory");
        }
    }
};
template <bool COLSCALE> struct EpiBf16S {
    static constexpr bool TWOSEG = false; static constexpr bool PERM = true;
    bf16_t* O; int ldc; const float* colscale;
    __device__ __forceinline__ void operator()(const f32x4 (&acc)[2][2][4][2], const Unit& u, int wr, int wc, int fr, int fq) const {
        const int row0 = u.pm * BM + wr * 64 + fr, col0 = u.pn * BM + wc * 32 + 8 * fq;
        f32x4 sv[2][2];
#pragma unroll
        for (int bj = 0; bj < 2; ++bj)
#pragma unroll
            for (int n = 0; n < 2; ++n) sv[bj][n] = COLSCALE ? *(const f32x4*)(colscale + col0 + bj * HALF + 4 * n) : (f32x4){1.f, 1.f, 1.f, 1.f};
#pragma unroll
        for (int ai = 0; ai < 2; ++ai)
#pragma unroll
            for (int m = 0; m < 4; ++m) { const int row = row0 + ai * HALF + m * 16; bf16_t* rowp = O + (size_t)row * ldc + col0;
#pragma unroll
                for (int bj = 0; bj < 2; ++bj) { f32x4 v0 = acc[ai][bj][m][0], v1 = acc[ai][bj][m][1]; if (COLSCALE) { v0 = v0 * sv[bj][0]; v1 = v1 * sv[bj][1]; }
                    u32x4 w; w.x = cvt_pk_bf16(v0[0], v0[1]); w.y = cvt_pk_bf16(v0[2], v0[3]); w.z = cvt_pk_bf16(v1[0], v1[1]); w.w = cvt_pk_bf16(v1[2], v1[3]);
                    *(u32x4*)(rowp + bj * HALF) = w; } }
    }
};
template <bool ADD> struct EpiMerge {
    static constexpr bool TWOSEG = false; static constexpr bool PERM = true;
    bf16_t* O; int ldc; const bf16_t* gate; int ldg;
    __device__ __forceinline__ void operator()(const f32x4 (&acc)[2][2][4][2], const Unit& u, int wr, int wc, int fr, int fq) const {
        const int row0 = u.pm * BM + wr * 64 + fr, col0 = u.pn * BM + wc * 32 + 8 * fq;
#pragma unroll
        for (int ai = 0; ai < 2; ++ai) {
            u32x4 gvv[4][2], ovv[4][2];
#pragma unroll
            for (int m = 0; m < 4; ++m)
#pragma unroll
                for (int bj = 0; bj < 2; ++bj) { const size_t r = (size_t)(row0 + ai * HALF + m * 16);
                    gvv[m][bj] = *(const u32x4*)(gate + r * ldg + col0 + bj * HALF);
                    if (ADD) ovv[m][bj] = *(const u32x4*)(O + r * ldc + col0 + bj * HALF); else ovv[m][bj] = (u32x4){0u, 0u, 0u, 0u}; }
            asm volatile("" ::: "memory");
#pragma unroll
            for (int m = 0; m < 4; ++m) { const size_t r = (size_t)(row0 + ai * HALF + m * 16);
#pragma unroll
                for (int bj = 0; bj < 2; ++bj) {
                    const u32x4 gv = gvv[m][bj], ov = ovv[m][bj];
                    const f32x4 a0 = acc[ai][bj][m][0], a1 = acc[ai][bj][m][1];
                    float v[8];
                    v[0] = sigmoidf_(bf_lo(gv.x)) * a0[0]; v[1] = sigmoidf_(bf_hi(gv.x)) * a0[1]; v[2] = sigmoidf_(bf_lo(gv.y)) * a0[2]; v[3] = sigmoidf_(bf_hi(gv.y)) * a0[3];
                    v[4] = sigmoidf_(bf_lo(gv.z)) * a1[0]; v[5] = sigmoidf_(bf_hi(gv.z)) * a1[1]; v[6] = sigmoidf_(bf_lo(gv.w)) * a1[2]; v[7] = sigmoidf_(bf_hi(gv.w)) * a1[3];
                    if (ADD) { v[0] += bf_lo(ov.x); v[1] += bf_hi(ov.x); v[2] += bf_lo(ov.y); v[3] += bf_hi(ov.y); v[4] += bf_lo(ov.z); v[5] += bf_hi(ov.z); v[6] += bf_lo(ov.w); v[7] += bf_hi(ov.w); }
                    u32x4 w; w.x = cvt_pk_bf16(v[0], v[1]); w.y = cvt_pk_bf16(v[2], v[3]); w.z = cvt_pk_bf16(v[4], v[5]); w.w = cvt_pk_bf16(v[6], v[7]);
                    *(u32x4*)(O + r * ldc + col0 + bj * HALF) = w; } }
            asm volatile("" ::: "memory");
        }
    }
};
__device__ __forceinline__ unsigned pack_u8x4(float a, float b, float c, float d) {
    return (unsigned)(a * 255.f + 0.5f) | ((unsigned)(b * 255.f + 0.5f) << 8) | ((unsigned)(c * 255.f + 0.5f) << 16) | ((unsigned)(d * 255.f + 0.5f) << 24); }
__device__ __forceinline__ void unpack_u8x8(unsigned lo, unsigned hi, float (&f)[8]) {
    f[0] = (float)(lo & 0xffu); f[1] = (float)((lo >> 8) & 0xffu); f[2] = (float)((lo >> 16) & 0xffu); f[3] = (float)(lo >> 24);
    f[4] = (float)(hi & 0xffu); f[5] = (float)((hi >> 8) & 0xffu); f[6] = (float)((hi >> 16) & 0xffu); f[7] = (float)(hi >> 24); }
struct EpiMerge2 {
    static constexpr bool TWOSEG = true; static constexpr bool PERM = true;
    bf16_t* O; int ldc; const unsigned char* gq; size_t gstride;
    __device__ __forceinline__ void mid(f32x4 (&acc)[2][2][4][2], const Unit& u, int wr, int wc, int fr, int fq) const {
        const int row0 = u.pm * BM + wr * 64 + fr; const size_t lo = (size_t)u.pn * 256 + (wc * 4 + fq) * 16;
#pragma unroll
        for (int ai = 0; ai < 2; ++ai) {
            u32x4 pv[4], mv[4];
#pragma unroll
            for (int m = 0; m < 4; ++m) { const size_t o = (size_t)(row0 + ai * HALF + m * 16) * 4096 + lo; pv[m] = *(const u32x4*)(gq + o); mv[m] = *(const u32x4*)(gq + gstride + o); }
            asm volatile("" ::: "memory");
#pragma unroll
            for (int m = 0; m < 4; ++m) { float a[8], b[8];
                unpack_u8x8(pv[m].x, pv[m].y, a); unpack_u8x8(mv[m].x, mv[m].y, b);
#pragma unroll
                for (int e = 0; e < 8; ++e) acc[ai][0][m][e >> 2][e & 3] *= a[e] * __builtin_amdgcn_rcpf(fmaxf(b[e], 0.5f));
                unpack_u8x8(pv[m].z, pv[m].w, a); unpack_u8x8(mv[m].z, mv[m].w, b);
#pragma unroll
                for (int e = 0; e < 8; ++e) acc[ai][1][m][e >> 2][e & 3] *= a[e] * __builtin_amdgcn_rcpf(fmaxf(b[e], 0.5f)); }
        }
    }
    __device__ __forceinline__ void operator()(const f32x4 (&acc)[2][2][4][2], const Unit& u, int wr, int wc, int fr, int fq) const {
        const int row0 = u.pm * BM + wr * 64 + fr, col0 = u.pn * BM + wc * 32 + 8 * fq; const size_t lo = (size_t)u.pn * 256 + (wc * 4 + fq) * 16;
#pragma unroll
        for (int ai = 0; ai < 2; ++ai) {
            u32x4 mv[4];
#pragma unroll
            for (int m = 0; m < 4; ++m) mv[m] = *(const u32x4*)(gq + gstride + (size_t)(row0 + ai * HALF + m * 16) * 4096 + lo);
            asm volatile("" ::: "memory");
#pragma unroll
            for (int m = 0; m < 4; ++m) { float b[8], v[8];
                unpack_u8x8(mv[m].x, mv[m].y, b);
#pragma unroll
                for (int e = 0; e < 8; ++e) v[e] = fmaxf(b[e], 0.5f) * (1.f / 255.f) * acc[ai][0][m][e >> 2][e & 3];
                *(u32x4*)(O + (size_t)(row0 + ai * HALF + m * 16) * ldc + col0) = pack8(v);
                unpack_u8x8(mv[m].z, mv[m].w, b);
#pragma unroll
                for (int e = 0; e < 8; ++e) v[e] = fmaxf(b[e], 0.5f) * (1.f / 255.f) * acc[ai][1][m][e >> 2][e & 3];
                *(u32x4*)(O + (size_t)(row0 + ai * HALF + m * 16) * ldc + col0 + HALF) = pack8(v); }
        }
    }
};
struct EpiWin {
    static constexpr bool TWOSEG = false; static constexpr bool PERM = true;
    bf16_t* Zb; int ldz; unsigned char* gq; size_t gstride; const float* rowss;
    __device__ __forceinline__ void operator()(const f32x4 (&acc)[2][2][4][2], const Unit& u, int wr, int wc, int fr, int fq) const {
        const int row0 = u.pm * BM + wr * 64 + fr;
        if (u.pn >= 14 && u.pn < 46) {
            const int which = u.pn >= 30, t = u.pn - (which ? 30 : 14);
            unsigned char* base = gq + (size_t)which * gstride + (size_t)t * 256 + (wc * 4 + fq) * 16;
#pragma unroll
            for (int ai = 0; ai < 2; ++ai)
#pragma unroll
                for (int m = 0; m < 4; ++m) { const int row = row0 + ai * HALF + m * 16; const float rse = -row_rstd(rowss, row) * LOG2E;
                    unsigned q[2][2];
#pragma unroll
                    for (int bj = 0; bj < 2; ++bj)
#pragma unroll
                        for (int n = 0; n < 2; ++n) { f32x4 t = acc[ai][bj][m][n] * rse;
#pragma unroll
                            for (int e = 0; e < 4; ++e) t[e] = __builtin_amdgcn_exp2f(t[e]);
                            t = t + 1.0f;
#pragma unroll
                            for (int e = 0; e < 4; ++e) t[e] = __builtin_amdgcn_rcpf(t[e]);
                            t = t * 255.f + 0.5f;
                            q[bj][n] = (unsigned)t[0] | ((unsigned)t[1] << 8) | ((unsigned)t[2] << 16) | ((unsigned)t[3] << 24); }
                    u32x4 w; w.x = q[0][0]; w.y = q[0][1]; w.z = q[1][0]; w.w = q[1][1];
                    *(u32x4*)(base + (size_t)row * 4096) = w; }
        } else {
            const int col0 = u.pn * BM + wc * 32 + 8 * fq;
#pragma unroll
            for (int ai = 0; ai < 2; ++ai)
#pragma unroll
                for (int m = 0; m < 4; ++m) { const int row = row0 + ai * HALF + m * 16; const float rs = row_rstd(rowss, row); bf16_t* rowp = Zb + (size_t)row * ldz + col0;
#pragma unroll
                    for (int bj = 0; bj < 2; ++bj) { const f32x4 v0 = acc[ai][bj][m][0] * rs, v1 = acc[ai][bj][m][1] * rs;
                        u32x4 w; w.x = cvt_pk_bf16(v0[0], v0[1]); w.y = cvt_pk_bf16(v0[2], v0[3]); w.z = cvt_pk_bf16(v1[0], v1[1]); w.w = cvt_pk_bf16(v1[2], v1[3]);
                        *(u32x4*)(rowp + bj * HALF) = w; } }
        }
    }
};
struct EpiKV {
    static constexpr bool TWOSEG = false; static constexpr bool PERM = true;
    bf16_t* O; int ldc; const float* gain; LAS float* tab;
    __device__ __forceinline__ void operator()(const f32x4 (&acc)[2][2][4][2], const Unit& u, int wr, int wc, int fr, int fq) const {
        const int row0 = u.pm * BM + wr * 64 + fr, col0 = u.pn * BM + wc * 32 + 8 * fq;
#pragma unroll
        for (int ai = 0; ai < 2; ++ai)
#pragma unroll
            for (int m = 0; m < 4; ++m) { const f32x4 a = acc[ai][0][m][0], b = acc[ai][0][m][1];
                float s = (a.x * a.x + a.y * a.y) + (a.z * a.z + a.w * a.w) + (b.x * b.x + b.y * b.y) + (b.z * b.z + b.w * b.w);
                s = xsum32(xsum16(s));
                if (fq == 0) tab[(ai * HALF + wr * 64 + m * 16 + fr) * 4 + wc] = s; }
        asm volatile("s_waitcnt lgkmcnt(0)" ::: "memory"); __builtin_amdgcn_s_barrier(); asm volatile("" ::: "memory");
        f32x4 g0 = *(const f32x4*)(gain + wc * 32 + 8 * fq), g1 = *(const f32x4*)(gain + wc * 32 + 8 * fq + 4);
#pragma unroll
        for (int ai = 0; ai < 2; ++ai)
#pragma unroll
            for (int m = 0; m < 4; ++m) { const int row = row0 + ai * HALF + m * 16;
                const f32x4 t = *(const LAS f32x4*)(tab + (ai * HALF + wr * 64 + m * 16 + fr) * 4);
                const float rs = rsqrtf(((t.x + t.y) + (t.z + t.w)) * (1.f / 128.f) + 1e-6f);
                bf16_t* rowp = O + (size_t)row * ldc + col0;
                { const f32x4 v0 = acc[ai][0][m][0] * g0 * rs, v1 = acc[ai][0][m][1] * g1 * rs;
                  u32x4 w; w.x = cvt_pk_bf16(v0[0], v0[1]); w.y = cvt_pk_bf16(v0[2], v0[3]); w.z = cvt_pk_bf16(v1[0], v1[1]); w.w = cvt_pk_bf16(v1[2], v1[3]); *(u32x4*)rowp = w; }
                { const f32x4 v0 = acc[ai][1][m][0], v1 = acc[ai][1][m][1];
                  u32x4 w; w.x = cvt_pk_bf16(v0[0], v0[1]); w.y = cvt_pk_bf16(v0[2], v0[3]); w.z = cvt_pk_bf16(v1[0], v1[1]); w.w = cvt_pk_bf16(v1[2], v1[3]); *(u32x4*)(rowp + HALF) = w; } }
        asm volatile("s_waitcnt lgkmcnt(0)" ::: "memory"); __builtin_amdgcn_s_barrier(); asm volatile("" ::: "memory");
    }
};
struct EpiF32Split {
    static constexpr bool TWOSEG = false; static constexpr bool PERM = false;
    float* O; int ldc; int tmask, tshift; size_t sstride; const float* rowss;
    __device__ __forceinline__ void operator()(const f32x4 (&acc)[2][2][4][2], const Unit& u, int wr, int wc, int fr, int fq) const {
        float* base = O + (size_t)(u.pn >> tshift) * sstride;
        const int row0 = u.pm * BM + wr * 64 + fr, col0 = (u.pn & tmask) * BM + wc * 32 + 4 * fq;
#pragma unroll
        for (int ai = 0; ai < 2; ++ai)
#pragma unroll
            for (int m = 0; m < 4; ++m) { const int row = row0 + ai * HALF + m * 16; const float rs = row_rstd(rowss, row); float* rowp = base + (size_t)row * ldc + col0;
#pragma unroll
                for (int bj = 0; bj < 2; ++bj)
#pragma unroll
                    for (int n = 0; n < 2; ++n) *(f32x4*)(rowp + bj * HALF + n * 16) = acc[ai][bj][m][n] * rs; }
    }
};

template <class Epi, class Sched, int PF = 0, bool ALIGN_EPI = true>
__device__ __forceinline__ void gemm_phase(LAS unsigned char* lds, const Gemm g, const Sched& S, const Epi& E) {
    int tid = threadIdx.x; asm volatile("" : "+v"(tid));
    const int wid = __builtin_amdgcn_readfirstlane(tid >> 6), lane = tid & 63, wr = wid >> 2, wc = wid & 3, fr = lane & 15, fq = lane >> 4;
    const int K = g.K, nt = K / BK;
    unsigned voffA[2], voffB[2];
#pragma unroll
    for (int i = 0; i < 2; ++i) { int R, C; stage_rc(tid * 16 + i * 8192, R, C); const int Rb = Epi::PERM ? ((R & ~31) + perm32(R & 31)) : R;
        voffA[i] = (unsigned)(R * g.lda + C) * 2u; voffB[i] = (unsigned)(Rb * g.ldb + C) * 2u; }
    const size_t kstep = (size_t)(BK * 2);
    const size_t hstepA = (size_t)HALF * g.lda * 2, hstepB = (size_t)HALF * g.ldb * 2;
    const unsigned ldsw = (unsigned)wid * 1024u;
    const int aoff = lds_byte(wr * 64 + fr, fq * 8), boff = lds_byte(wc * 32 + fr, fq * 8);
#define PG8_SA(b, h) (((b) * 2 + (h)) * HTB)
#define PG8_SB(b, h) ((4 + (b) * 2 + (h)) * HTB)
#define PG8_STAGE(bufoff, gbase, voff) do { _Pragma("unroll") for (int _i = 0; _i < 2; ++_i) \
        __builtin_amdgcn_global_load_lds((const unsigned*)((const char*)(gbase) + (voff)[_i]), (LAS unsigned*)(lds + (bufoff) + ldsw + _i * 8192), 16, 0, 0); } while (0)
#define PG8_LDA(dst, b, h) do { _Pragma("unroll") for (int m = 0; m < 4; ++m) _Pragma("unroll") for (int k = 0; k < 2; ++k) dst[m][k] = *(const LAS bf16x8*)(lds + PG8_SA(b, h) + aoff + m * 2048 + k * 1024); } while (0)
#define PG8_LDB(dst, b, h) do { _Pragma("unroll") for (int n = 0; n < 2; ++n) _Pragma("unroll") for (int k = 0; k < 2; ++k) dst[n][k] = *(const LAS bf16x8*)(lds + PG8_SB(b, h) + boff + n * 2048 + k * 1024); } while (0)
#define PG8_MMA(ai, bj, At, Bt) do { __builtin_amdgcn_s_setprio(1); _Pragma("unroll") for (int m = 0; m < 4; ++m) _Pragma("unroll") for (int n = 0; n < 2; ++n) _Pragma("unroll") for (int k = 0; k < 2; ++k) \
        acc[ai][bj][m][n] = __builtin_amdgcn_mfma_f32_16x16x32_bf16(Bt[n][k], At[m][k], acc[ai][bj][m][n], 0, 0, 0); __builtin_amdgcn_s_setprio(0); } while (0)
#define PG8_WAIT_V(n) asm volatile("s_waitcnt vmcnt(" #n ")" ::: "memory")
#define PG8_WAIT_L(n) asm volatile("s_waitcnt lgkmcnt(" #n ")" ::: "memory")
#define PG8_BAR __builtin_amdgcn_s_barrier()
#define PG8_SCHED __builtin_amdgcn_sched_barrier(0)
#define PG8_APTR(u) ((const char*)((u).seg ? g.A2 : g.A) + ((size_t)(u).pm * BM * g.lda + (size_t)((u).pn >> g.ashift) * g.astride) * 2)
#define PG8_BPTR(u) ((const char*)((u).seg ? g.Bt2 : g.Bt) + ((size_t)((u).pn & g.bmask) * BM * g.ldb + (size_t)((u).pn >> g.ashift) * g.bstride) * 2)
#define PG8_KITER(t) do { \
            const bool last = (t == nt - 2); \
            const char* a1 = cA + (size_t)(t + 1) * kstep; \
            const char* a2 = last ? nA : cA + (size_t)(t + 2) * kstep; const char* b2 = last ? nB : cB + (size_t)(t + 2) * kstep; \
            const char* a3 = a2 + kstep; const char* b3 = b2 + kstep; \
              \
            PG8_LDB(B0, 0, 0); PG8_LDB(B1, 0, 1); PG8_SCHED; PG8_LDA(At, 0, 0); PG8_STAGE(PG8_SA(1, 1), a1 + hstepA, voffA); \
            PG8_WAIT_VK(); PG8_WAIT_L(0); PG8_BAR; PG8_MMA(0, 0, At, B0); PG8_MMA(0, 1, At, B1); PG8_BAR; PG8_SCHED; \
              \
            PG8_LDA(At, 0, 1); PG8_STAGE(PG8_SB(0, 0), b2, voffB); PG8_STAGE(PG8_SB(0, 1), b2 + hstepB, voffB); PG8_STAGE(PG8_SA(0, 0), a2, voffA); \
            if constexpr (PF > 0) { const int kt = t + 2 + PF; const char* p = kt < nt ? pfc + (size_t)kt * kstep : pfn + (size_t)(kt - nt) * kstep; PG8_TOUCH(p); } \
            PG8_WAIT_VK(); PG8_WAIT_L(0); PG8_BAR; PG8_MMA(1, 0, At, B0); PG8_MMA(1, 1, At, B1); PG8_BAR; PG8_SCHED; \
              \
            PG8_LDB(B0, 1, 0); PG8_LDB(B1, 1, 1); PG8_SCHED; PG8_LDA(At, 1, 0); PG8_STAGE(PG8_SA(0, 1), a2 + hstepA, voffA); \
            PG8_WAIT_VK(); PG8_WAIT_L(0); PG8_BAR; PG8_MMA(0, 0, At, B0); PG8_MMA(0, 1, At, B1); PG8_BAR; PG8_SCHED; \
              \
            PG8_LDA(At, 1, 1); PG8_STAGE(PG8_SB(1, 0), b3, voffB); PG8_STAGE(PG8_SB(1, 1), b3 + hstepB, voffB); PG8_STAGE(PG8_SA(1, 0), a3, voffA); \
            if constexpr (PF > 0) { const int kt = t + 3 + PF; const char* p = kt < nt ? pfc + (size_t)kt * kstep : pfn + (size_t)(kt - nt) * kstep; PG8_TOUCH(p); } \
            PG8_WAIT_VK(); PG8_WAIT_L(0); PG8_BAR; PG8_MMA(1, 0, At, B0); PG8_MMA(1, 1, At, B1); PG8_BAR; PG8_SCHED; \
        } while (0)
    Unit cur, nxt; int ui = 0;
    if (!S.next(0, cur)) return;
    f32x4 acc[2][2][4][2];
#pragma unroll
    for (int a = 0; a < 2; ++a)
#pragma unroll
        for (int b = 0; b < 2; ++b)
#pragma unroll
            for (int m = 0; m < 4; ++m)
#pragma unroll
                for (int n = 0; n < 2; ++n) acc[a][b][m][n] = (f32x4){0.f, 0.f, 0.f, 0.f};
    bf16x8 At[4][2], B0[2][2], B1[2][2];
    const char* cA = PG8_APTR(cur); const char* cB = PG8_BPTR(cur);
    unsigned pfd = 0u;
    const size_t pfrow = (tid < 256) ? (size_t)tid * g.lda * 2 : (size_t)(tid - 256) * g.ldb * 2;
#define PG8_PFPTR(pa, pb) (((tid < 256) ? (pa) : (pb)) + pfrow)
#define PG8_TOUCH(p) asm volatile("global_load_dword %0, %1, off" : "+v"(pfd) : "v"(p) : "memory")
#define PG8_WAIT_VK() do { if constexpr (PF > 0) PG8_WAIT_V(9); else PG8_WAIT_V(8); } while (0)
    PG8_STAGE(PG8_SB(0, 0), cB, voffB); PG8_STAGE(PG8_SB(0, 1), cB + hstepB, voffB); PG8_STAGE(PG8_SA(0, 0), cA, voffA); PG8_STAGE(PG8_SA(0, 1), cA + hstepA, voffA);
    if (wr == 1) PG8_BAR;
    PG8_WAIT_V(2); PG8_BAR;
    PG8_STAGE(PG8_SB(1, 0), cB + kstep, voffB); PG8_STAGE(PG8_SA(1, 0), cA + kstep, voffA); PG8_STAGE(PG8_SB(1, 1), cB + hstepB + kstep, voffB);
    PG8_WAIT_V(6); PG8_BAR;
    if constexpr (PF > 0) { const char* p0 = PG8_PFPTR(cA, cB) + (size_t)(2 + PF) * kstep; PG8_TOUCH(p0); }
    for (;;) {
        const bool has_next = S.next(ui + 1, nxt);
        const char* nA = has_next ? PG8_APTR(nxt) : cA; const char* nB = has_next ? PG8_BPTR(nxt) : cB;
        const char* pfc = PG8_PFPTR(cA, cB); const char* pfn = PG8_PFPTR(nA, nB);
        PG8_KITER(0);
        for (int t = 2; t < nt; t += 2) PG8_KITER(t);
        if constexpr (ALIGN_EPI) { if (wr == 0) PG8_BAR; }
#if defined(PROBE_MODE) && PROBE_MODE == 2
        if (blockIdx.x == 0 && threadIdx.x == 0) { volatile LAS unsigned long long* pw_ = (volatile LAS unsigned long long*)(lds + 135168); if (pw_[4]) { pw_[3] += __builtin_amdgcn_s_memrealtime() - pw_[5]; } }
#endif
        bool keep = false;
        {
            int te = threadIdx.x; asm volatile("" : "+v"(te));
            const int widE = __builtin_amdgcn_readfirstlane(te >> 6), laneE = te & 63, wrE = widE >> 2, wcE = widE & 3, frE = laneE & 15, fqE = laneE >> 4;
            if constexpr (Epi::TWOSEG) { if (cur.seg == 0) { E.mid(acc, cur, wrE, wcE, frE, fqE); keep = true; } else E(acc, cur, wrE, wcE, frE, fqE); }
            else E(acc, cur, wrE, wcE, frE, fqE); }
#if defined(PROBE_MODE) && PROBE_MODE == 2
        if (blockIdx.x == 0 && threadIdx.x == 0) { volatile LAS unsigned long long* pw_ = (volatile LAS unsigned long long*)(lds + 135168); if (pw_[4]) { pw_[5] = __builtin_amdgcn_s_memrealtime(); } }
#endif
        if (!has_next) break;
        if (!keep) {
#pragma unroll
        for (int a = 0; a < 2; ++a)
#pragma unroll
            for (int b = 0; b < 2; ++b)
#pragma unroll
                for (int m = 0; m < 4; ++m)
#pragma unroll
                    for (int n = 0; n < 2; ++n) acc[a][b][m][n] = (f32x4){0.f, 0.f, 0.f, 0.f};
        }
        cur = nxt; cA = nA; cB = nB; ++ui;
        if constexpr (ALIGN_EPI) { if (wr == 1) PG8_BAR; }
    }
    PG8_WAIT_V(0);
    asm volatile("" :: "v"(pfd));
    if constexpr (!ALIGN_EPI) { if (wr == 0) PG8_BAR; }
    PG8_BAR;
#undef PG8_SA
#undef PG8_SB
#undef PG8_STAGE
#undef PG8_LDA
#undef PG8_LDB
#undef PG8_MMA
#undef PG8_WAIT_V
#undef PG8_WAIT_L
#undef PG8_BAR
#undef PG8_SCHED
#undef PG8_APTR
#undef PG8_BPTR
#undef PG8_PFPTR
#undef PG8_TOUCH
#undef PG8_WAIT_VK
#undef PG8_KITER
}
}

namespace att {
constexpr int KVBLK = 64, QBLK = 32, NW = 8;
constexpr int SHM_V = KVBLK * 128 * 2;
constexpr float THR2 = 11.5f;
#define ATT_KSWZ(row, colB, KROW) ((row) * (KROW) + (colB))
#define ATT_SBAR() __builtin_amdgcn_sched_barrier(0)
__device__ __forceinline__ int crow(int r, int hi) { return (r & 3) + 8 * (r >> 2) + 4 * hi; }

__device__ __forceinline__ void partialSM(f32x16& p0, f32x16& p1, float& m_reg, float& mn, float& alpha) {
    float pmax = p0[0];
#pragma unroll
    for (int r = 1; r < 16; ++r) pmax = fmaxf(pmax, p0[r]);
#pragma unroll
    for (int r = 0; r < 16; ++r) pmax = fmaxf(pmax, p1[r]);
    { auto rr = __builtin_amdgcn_permlane32_swap(__float_as_uint(pmax), __float_as_uint(pmax), false, false);
      pmax = fmaxf(__uint_as_float(rr[0]), __uint_as_float(rr[1])); }
    if (__builtin_expect(__all(pmax - m_reg <= THR2), 1)) { mn = m_reg; alpha = 1.f; }
    else { mn = fmaxf(m_reg, pmax); alpha = __builtin_amdgcn_exp2f(m_reg - mn); m_reg = mn; }
#pragma unroll
    for (int r = 0; r < 16; ++r) p0[r] = p0[r] - mn;
#pragma unroll
    for (int r = 0; r < 16; ++r) p1[r] = p1[r] - mn;
#pragma unroll
    for (int r = 0; r < 16; ++r) p0[r] = __builtin_amdgcn_exp2f(p0[r]);
}
__device__ __forceinline__ void finishSM(f32x16& p0, f32x16& p1, float alpha, float& l_reg, bf16x8& pa0, bf16x8& pa1, bf16x8& pa2, bf16x8& pa3) {
#pragma unroll
    for (int r = 0; r < 16; ++r) p1[r] = __builtin_amdgcn_exp2f(p1[r]);
    float ps = 0;
#pragma unroll
    for (int r = 0; r < 16; ++r) ps += p0[r];
#pragma unroll
    for (int r = 0; r < 16; ++r) ps += p1[r];
    { auto rr = __builtin_amdgcn_permlane32_swap(__float_as_uint(ps), __float_as_uint(ps), false, false);
      ps = __uint_as_float(rr[0]) + __uint_as_float(rr[1]); }
    l_reg = l_reg * alpha + ps;
#define ATT_PK4(P, BASE, OUT) do { unsigned a0 = cvt_pk_bf16(P[BASE + 0], P[BASE + 1]), a1 = cvt_pk_bf16(P[BASE + 2], P[BASE + 3]);   \
    unsigned b0 = cvt_pk_bf16(P[BASE + 4], P[BASE + 5]), b1 = cvt_pk_bf16(P[BASE + 6], P[BASE + 7]);                              \
    auto r0 = __builtin_amdgcn_permlane32_swap(a0, b0, false, false); auto r1 = __builtin_amdgcn_permlane32_swap(a1, b1, false, false); \
    u32x4 w = {r0[0], r1[0], r0[1], r1[1]}; OUT = __builtin_bit_cast(bf16x8, w); } while (0)
    ATT_PK4(p0, 0, pa0); ATT_PK4(p0, 8, pa1); ATT_PK4(p1, 0, pa2); ATT_PK4(p1, 8, pa3);
#undef ATT_PK4
}
#ifndef QKT_PIN
#define QKT_PIN 1
#endif
template <int DK> __device__ __forceinline__ void qkt(f32x16& p0, f32x16& p1, const char* Ks, const bf16x8* qr, int r32, int hi) {
    p0 = f32x16{}; p1 = f32x16{};
    __builtin_amdgcn_s_setprio(1);
#pragma unroll
    for (int d0 = 0; d0 < DK / 16; ++d0) { const int cb = (d0 * 16 + hi * 8) * 2;
        const bf16x8 b0 = *reinterpret_cast<const bf16x8*>(Ks + ATT_KSWZ(r32, cb, DK * 2 + 16));
        const bf16x8 b1 = *reinterpret_cast<const bf16x8*>(Ks + ATT_KSWZ(32 + r32, cb, DK * 2 + 16));
        p0 = __builtin_amdgcn_mfma_f32_32x32x16_bf16(b0, qr[d0], p0, 0, 0, 0);
        p1 = __builtin_amdgcn_mfma_f32_32x32x16_bf16(b1, qr[d0], p1, 0, 0, 0);
        if (QKT_PIN && (d0 % 3) == 2) ATT_SBAR(); }
    __builtin_amdgcn_s_setprio(0);
}
template <int DK> __device__ __forceinline__ void qkt_pipe(f32x16& p0, f32x16& p1, const char* Ks, const bf16x8* qr, int r32, int hi) {
    constexpr int ND = DK / 16, KR = DK * 2 + 16;
    const char* r0 = Ks + ATT_KSWZ(r32, hi * 16, KR); const char* r1 = Ks + ATT_KSWZ(32 + r32, hi * 16, KR);
    bf16x8 ka[3], kb[3];
#define QP_LD(d, s) do { ka[s] = *reinterpret_cast<const bf16x8*>(r0 + (d) * 32); kb[s] = *reinterpret_cast<const bf16x8*>(r1 + (d) * 32); } while (0)
    QP_LD(0, 0); QP_LD(1, 1); QP_LD(2, 2); ATT_SBAR();
    p0 = f32x16{}; p1 = f32x16{};
    __builtin_amdgcn_s_setprio(1);
#pragma unroll
    for (int d0 = 0; d0 < ND; ++d0) {
        p0 = __builtin_amdgcn_mfma_f32_32x32x16_bf16(ka[d0 % 3], qr[d0], p0, 0, 0, 0);
        p1 = __builtin_amdgcn_mfma_f32_32x32x16_bf16(kb[d0 % 3], qr[d0], p1, 0, 0, 0);
        if (d0 + 3 < ND) QP_LD(d0 + 3, d0 % 3);
        ATT_SBAR(); }
    __builtin_amdgcn_s_setprio(0);
#undef QP_LD
}
__device__ __forceinline__ void cmask(f32x16& p0, f32x16& p1, int t, int qrel, int hi) {
    const float ninf = -__builtin_inff();
#pragma unroll
    for (int r = 0; r < 16; ++r) { const int k0 = 64 * t + crow(r, hi); if (k0 > qrel) p0[r] = ninf; if (k0 + 32 > qrel) p1[r] = ninf; }
}
__device__ __forceinline__ int v_st(int k, int c) { const int kk = (k & ~0xC) | ((k & 4) << 1) | ((k & 8) >> 1); return ((kk >> 3) * 4 + (c >> 5)) * 512 + ((kk & 7) * 32 + (c & 31)) * 2; }
__device__ __forceinline__ int v_rd_base(int lane) { return ((lane & 3) << 3) | (((lane >> 2) & 3) << 6) | (((lane >> 4) & 1) << 5) | (((lane >> 5) & 1) << 8); }
constexpr int v_rd_off(int d0, int ks, int half) { return d0 * 512 + ks * 4096 + half * 2048; }
template <int OFF> __device__ __forceinline__ s16x4 tr_read(int vb) {
    s16x4 r; asm volatile("ds_read_b64_tr_b16 %0, %1 offset:%2" : "=&v"(r) : "v"(vb), "i"(OFF) : "memory"); return r;
}
template <int D0> __device__ __forceinline__ void pv_one(f32x16& od, int vb, bf16x8 pa0, bf16x8 pa1, bf16x8 pa2, bf16x8 pa3) {
    const s16x4 l0 = tr_read<v_rd_off(D0, 0, 0)>(vb), h0 = tr_read<v_rd_off(D0, 0, 1)>(vb), l1 = tr_read<v_rd_off(D0, 1, 0)>(vb), h1 = tr_read<v_rd_off(D0, 1, 1)>(vb);
    const s16x4 l2 = tr_read<v_rd_off(D0, 2, 0)>(vb), h2 = tr_read<v_rd_off(D0, 2, 1)>(vb), l3 = tr_read<v_rd_off(D0, 3, 0)>(vb), h3 = tr_read<v_rd_off(D0, 3, 1)>(vb);
    asm volatile("s_waitcnt lgkmcnt(0)" ::: "memory"); ATT_SBAR();
    __builtin_amdgcn_s_setprio(1);
#define ATT_PK(L, H) (bf16x8){L[0], L[1], L[2], L[3], H[0], H[1], H[2], H[3]}
    od = __builtin_amdgcn_mfma_f32_32x32x16_bf16(pa0, ATT_PK(l0, h0), od, 0, 0, 0);
    od = __builtin_amdgcn_mfma_f32_32x32x16_bf16(pa1, ATT_PK(l1, h1), od, 0, 0, 0);
    od = __builtin_amdgcn_mfma_f32_32x32x16_bf16(pa2, ATT_PK(l2, h2), od, 0, 0, 0);
    od = __builtin_amdgcn_mfma_f32_32x32x16_bf16(pa3, ATT_PK(l3, h3), od, 0, 0, 0);
    __builtin_amdgcn_s_setprio(0);
#undef ATT_PK
}
__device__ __forceinline__ void pv_d0(f32x16* o, int vb, bf16x8 pa0, bf16x8 pa1, bf16x8 pa2, bf16x8 pa3) {
#define PV_TRB(off) __builtin_amdgcn_ds_read_tr16_b64_v4i16((LAS s16x4*)(unsigned)(vb + (off)))
#define PV_RD(D0, X) do { X[0] = PV_TRB(v_rd_off(D0, 0, 0)); X[1] = PV_TRB(v_rd_off(D0, 0, 1)); X[2] = PV_TRB(v_rd_off(D0, 1, 0)); X[3] = PV_TRB(v_rd_off(D0, 1, 1)); \
                          X[4] = PV_TRB(v_rd_off(D0, 2, 0)); X[5] = PV_TRB(v_rd_off(D0, 2, 1)); X[6] = PV_TRB(v_rd_off(D0, 3, 0)); X[7] = PV_TRB(v_rd_off(D0, 3, 1)); } while (0)
#define PV_PK(L, H) (bf16x8){L[0], L[1], L[2], L[3], H[0], H[1], H[2], H[3]}
#define PV_MM(D0, X) do { __builtin_amdgcn_s_setprio(1); o[D0] = __builtin_amdgcn_mfma_f32_32x32x16_bf16(pa0, PV_PK(X[0], X[1]), o[D0], 0, 0, 0); o[D0] = __builtin_amdgcn_mfma_f32_32x32x16_bf16(pa1, PV_PK(X[2], X[3]), o[D0], 0, 0, 0); \
                           o[D0] = __builtin_amdgcn_mfma_f32_32x32x16_bf16(pa2, PV_PK(X[4], X[5]), o[D0], 0, 0, 0); o[D0] = __builtin_amdgcn_mfma_f32_32x32x16_bf16(pa3, PV_PK(X[6], X[7]), o[D0], 0, 0, 0); __builtin_amdgcn_s_setprio(0); } while (0)
    s16x4 F[8], G[8];
    PV_RD(0, F); ATT_SBAR();
    PV_RD(1, G); ATT_SBAR(); PV_MM(0, F); ATT_SBAR();
    PV_RD(2, F); ATT_SBAR(); PV_MM(1, G); ATT_SBAR();
    PV_RD(3, G); ATT_SBAR(); PV_MM(2, F); ATT_SBAR();
    PV_MM(3, G);
#undef PV_TRB
#undef PV_RD
#undef PV_PK
#undef PV_MM
}

template <int DK, bool CAUSAL>
__device__ __forceinline__ void attn_unit(const bf16x8 (&qr)[DK / 16], const bf16_t* __restrict__ Kn, int ldk, const bf16_t* __restrict__ Kr, int ldkr,
                                          const bf16_t* __restrict__ V, int ldv, bf16_t* __restrict__ O, int ldo, int NT, char* lds) {
    constexpr int KROW = DK * 2 + 16, SHM_K = KVBLK * KROW;
    int tid = threadIdx.x; asm volatile("" : "+v"(tid));
    const int wid = tid >> 6, lane = tid & 63, r32 = lane & 31, hi = lane >> 5;
    char* V_lds = lds; char* K_lds = lds + 2 * SHM_V;
    float* wsf = (float*)(lds + 2 * SHM_V + 2 * SHM_K) + wid * 64; float* li_l = wsf; float* al_l = wsf + 32;
    float m_reg = -1e30f, l_reg = 0; f32x16 o[4] = {};
    const int sr = tid >> 4, sc = (tid & 15) * 8, vst0 = v_st(sr, sc), vst1 = v_st(32 + sr, sc);
    const int rr = tid >> 3, rc = (tid & 7) * 8;
    const int vb0 = (int)(uintptr_t)V_lds + v_rd_base(lane);
    bf16x8 vs0, vs1, ks0, ks1, kr0;
#define SLOAD(k0) do { vs0 = *(const bf16x8*)(V + (size_t)((k0) + sr) * ldv + sc); vs1 = *(const bf16x8*)(V + (size_t)((k0) + 32 + sr) * ldv + sc); \
    ks0 = *(const bf16x8*)(Kn + (size_t)((k0) + sr) * ldk + sc); ks1 = *(const bf16x8*)(Kn + (size_t)((k0) + 32 + sr) * ldk + sc); \
    if constexpr (DK == 192) kr0 = *(const bf16x8*)(Kr + (size_t)((k0) + rr) * ldkr + rc); } while (0)
#define SWRITE(b) do { *(bf16x8*)(V_lds + (b) * SHM_V + vst0) = vs0; *(bf16x8*)(V_lds + (b) * SHM_V + vst1) = vs1; const int kc = sc * 2; \
    *(bf16x8*)(K_lds + (b) * SHM_K + ATT_KSWZ(sr, kc, KROW)) = ks0; *(bf16x8*)(K_lds + (b) * SHM_K + ATT_KSWZ(32 + sr, kc, KROW)) = ks1; \
    if constexpr (DK == 192) *(bf16x8*)(K_lds + (b) * SHM_K + ATT_KSWZ(rr, 256 + rc * 2, KROW)) = kr0; } while (0)
#define SWAIT() asm volatile("s_waitcnt vmcnt(0)" ::: "memory")
#define RESC(a) do { if (__any((a) < 1.f)) { if (hi == 0) al_l[r32] = (a); asm volatile("s_waitcnt lgkmcnt(0)" ::: "memory"); \
    _Pragma("unroll") for (int d = 0; d < 4; ++d) _Pragma("unroll") for (int r = 0; r < 16; ++r) o[d][r] *= al_l[crow(r, hi)]; } } while (0)
#define MASK(P0, P1, j) do { if (CAUSAL) { const int t_ = (j) - (NT - 4); if (t_ >= 0 && 64 * t_ + 63 > 32 * wid) cmask(P0, P1, t_, 32 * wid + r32, hi); } } while (0)
    f32x16 p0, p1; float mn, al; bf16x8 pa0, pa1, pa2, pa3;
    SLOAD(0); SWAIT(); SWRITE(0); __syncthreads();
#define ATT_STEP(j, b) do { \
        if ((j) + 1 < NT) SLOAD(((j) + 1) * KVBLK); ATT_SBAR(); \
        qkt<DK>(p0, p1, K_lds + (b) * SHM_K, qr, r32, hi); MASK(p0, p1, (j)); partialSM(p0, p1, m_reg, mn, al); RESC(al); \
        finishSM(p0, p1, al, l_reg, pa0, pa1, pa2, pa3); ATT_SBAR(); \
        pv_d0(o, vb0 + (b) * SHM_V, pa0, pa1, pa2, pa3); \
        if ((j) + 1 < NT) { SWAIT(); SWRITE((b) ^ 1); } \
        __syncthreads(); } while (0)
    for (int j = 0; j < NT; j += 2) { ATT_STEP(j, 0); ATT_STEP(j + 1, 1); }
#undef ATT_STEP
    if (hi == 0) li_l[r32] = l_reg; asm volatile("s_waitcnt lgkmcnt(0)" ::: "memory");
    float rli[16];
#pragma unroll
    for (int r = 0; r < 16; ++r) rli[r] = __builtin_amdgcn_rcpf(li_l[crow(r, hi)]);
    bf16_t* Ow = O + (size_t)(wid * QBLK) * ldo;
#pragma unroll
    for (int r = 0; r < 16; ++r) { const int orow = crow(r, hi);
#pragma unroll
        for (int d0 = 0; d0 < 4; ++d0) { const unsigned w = cvt_pk_bf16(o[d0][r] * rli[r], 0.f); Ow[(size_t)orow * ldo + d0 * 32 + r32] = (bf16_t)(w & 0xffffu); } }
    __syncthreads();
#undef SLOAD
#undef SWRITE
#undef SWAIT
#undef RESC
#undef MASK
}


template <int DK, bool CAUSAL>
__device__ __forceinline__ void attn_unit_pp(const bf16x8 (&qr)[DK / 16], const bf16_t* __restrict__ Kn, int ldk, const bf16_t* __restrict__ Kr, int ldkr,
                                             const bf16_t* __restrict__ V, int ldv, bf16_t* __restrict__ O, int ldo, int NT, char* lds) {
    constexpr int KROW = DK * 2 + 16, SHM_K = KVBLK * KROW;
    int tid = threadIdx.x; asm volatile("" : "+v"(tid));
    const int wid = __builtin_amdgcn_readfirstlane(tid >> 6), lane = tid & 63, r32 = lane & 31, hi = lane >> 5, half = wid >> 2;
    char* V_lds = lds; char* K_lds = lds + 2 * SHM_V;
    float* wsf = (float*)(lds + 2 * SHM_V + 2 * SHM_K) + wid * 64; float* li_l = wsf; float* al_l = wsf + 32;
    float m_reg = -1e30f, l_reg = 0; f32x16 o[4] = {};
    const int sr = tid >> 4, sc = (tid & 15) * 8, vst0 = v_st(sr, sc), vst1 = v_st(32 + sr, sc);
    const int rr = tid >> 3, rc = (tid & 7) * 8;
    const int vb0 = (int)(uintptr_t)V_lds + v_rd_base(lane);
    bf16x8 vs0, vs1, ks0, ks1, kr0;
    const __amdgpu_buffer_rsrc_t rsV = __builtin_amdgcn_make_buffer_rsrc((void*)V, (short)0, 0x7fffffff, 0x00020000);
    const __amdgpu_buffer_rsrc_t rsK = __builtin_amdgcn_make_buffer_rsrc((void*)Kn, (short)0, 0x7fffffff, 0x00020000);
    const __amdgpu_buffer_rsrc_t rsR = __builtin_amdgcn_make_buffer_rsrc((void*)(DK == 192 ? Kr : Kn), (short)0, 0x7fffffff, 0x00020000);
    const unsigned ovl = (unsigned)(sr * ldv + sc) * 2u, okl = (unsigned)(sr * ldk + sc) * 2u, orl = (unsigned)(rr * ldkr + rc) * 2u;
#define BLD(rs, voff, soff) __builtin_bit_cast(bf16x8, __builtin_amdgcn_raw_buffer_load_b128((rs), (voff), (soff), 0))
#define KLOAD(k0) do { const unsigned sk_ = (unsigned)(k0) * (unsigned)ldk * 2u; ks0 = BLD(rsK, okl, sk_); ks1 = BLD(rsK, okl + 64u * (unsigned)ldk, sk_); \
    if constexpr (DK == 192) kr0 = BLD(rsR, orl, (unsigned)(k0) * (unsigned)ldkr * 2u); } while (0)
#define VLOAD(k0) do { const unsigned sv_ = (unsigned)(k0) * (unsigned)ldv * 2u; vs0 = BLD(rsV, ovl, sv_); vs1 = BLD(rsV, ovl + 64u * (unsigned)ldv, sv_); } while (0)
#define KWRITE(boff) do { const int kc = sc * 2; *(bf16x8*)(K_lds + (boff) + ATT_KSWZ(sr, kc, KROW)) = ks0; *(bf16x8*)(K_lds + (boff) + ATT_KSWZ(32 + sr, kc, KROW)) = ks1; \
    if constexpr (DK == 192) *(bf16x8*)(K_lds + (boff) + ATT_KSWZ(rr, 256 + rc * 2, KROW)) = kr0; } while (0)
#define VWRITE(boff) do { *(bf16x8*)(V_lds + (boff) + vst0) = vs0; *(bf16x8*)(V_lds + (boff) + vst1) = vs1; } while (0)
#define VMWAIT() asm volatile("s_waitcnt vmcnt(0)" ::: "memory")
#define PPBAR() do { ATT_SBAR(); asm volatile("s_waitcnt lgkmcnt(0)" ::: "memory"); __builtin_amdgcn_s_barrier(); asm volatile("" ::: "memory"); ATT_SBAR(); } while (0)
#define RESC(a) do { if (__any((a) < 1.f)) { if (hi == 0) al_l[r32] = (a); asm volatile("s_waitcnt lgkmcnt(0)" ::: "memory"); \
    _Pragma("unroll") for (int d = 0; d < 4; ++d) _Pragma("unroll") for (int r = 0; r < 16; ++r) o[d][r] *= al_l[crow(r, hi)]; } } while (0)
#define MASK(P0, P1, j) do { if (CAUSAL) { const int t_ = (j) - (NT - 4); if (t_ >= 0 && 64 * t_ + 63 > 32 * wid) cmask(P0, P1, t_, 32 * wid + r32, hi); } } while (0)
    f32x16 p0, p1; float mn, al; bf16x8 pa0, pa1, pa2, pa3;
    KLOAD(KVBLK); { const bf16x8 t0 = ks0, t1 = ks1, t2 = kr0;
      KLOAD(0); VLOAD(0); VMWAIT(); KWRITE(0); VWRITE(0);
      ks0 = t0; ks1 = t1; if constexpr (DK == 192) kr0 = t2; KWRITE(SHM_K); }
    PPBAR();
    { const int kt0 = 1 + half, vt0 = half; if (kt0 < NT) KLOAD(kt0 * KVBLK); if (vt0 < NT) VLOAD(vt0 * KVBLK); }
    if (half == 1) PPBAR();
#define PP_STEP(s, PAR) do { \
        const int kt_ = (s) + 1 + half, vt_ = (s) + half; \
        if ((s) < NT) qkt_pipe<DK>(p0, p1, K_lds + (PAR) * SHM_K, qr, r32, hi); \
        if ((s) >= 1) pv_d0(o, vb0 + ((PAR) ^ 1) * SHM_V, pa0, pa1, pa2, pa3); \
        PPBAR(); \
        if ((s) < NT) { MASK(p0, p1, (s)); partialSM(p0, p1, m_reg, mn, al); RESC(al); finishSM(p0, p1, al, l_reg, pa0, pa1, pa2, pa3); } \
        VMWAIT(); \
        if (kt_ < NT) KWRITE((kt_ & 1) * SHM_K); if (vt_ < NT) VWRITE((vt_ & 1) * SHM_V); \
        if (kt_ + 1 < NT) KLOAD((kt_ + 1) * KVBLK); if (vt_ + 1 < NT) VLOAD((vt_ + 1) * KVBLK);        \
        PPBAR(); } while (0)
    for (int s = 0; s < NT; s += 2) { PP_STEP(s, 0); PP_STEP(s + 1, 1); }
    PP_STEP(NT, 0);
#undef PP_STEP
    if (half == 0) PPBAR();
    {
        int t2 = threadIdx.x; asm volatile("" : "+v"(t2));
        const int wid2 = t2 >> 6, r2 = t2 & 31, hi2 = (t2 >> 5) & 1;
        float* li2 = (float*)(lds + 2 * SHM_V + 2 * SHM_K) + wid2 * 64;
        if (hi2 == 0) li2[r2] = l_reg; asm volatile("s_waitcnt lgkmcnt(0)" ::: "memory");
        bf16_t* Ow = O + (size_t)(wid2 * QBLK) * ldo + r2;
#pragma unroll
        for (int r = 0; r < 16; ++r) { const int orow = crow(r, hi2); const float rl = __builtin_amdgcn_rcpf(li2[orow]);
#pragma unroll
            for (int d0 = 0; d0 < 4; ++d0) { const unsigned w = cvt_pk_bf16(o[d0][r] * rl, 0.f); Ow[(size_t)orow * ldo + d0 * 32] = (bf16_t)(w & 0xffffu); } }
    }
    PPBAR();
#undef KLOAD
#undef BLD
#undef VLOAD
#undef KWRITE
#undef VWRITE
#undef VMWAIT
#undef PPBAR
#undef RESC
#undef MASK
}
}

#define XB_TMO      128
#define XB_XCNT(j)  (256  + 64 * (j))
#define XB_XSUB(j)  (1280 + 64 * (j))
#define XB_XGEN(j)  (2304 + 64 * (j))
#define XB_TOP      3328
#define XB_TOPGEN   3392
#define XCD_BAR_WORDS 3456
#define XB_SPIN_CAP (1u << 18)
__device__ __forceinline__ unsigned xb_ld(unsigned* p)              { return __hip_atomic_load(p, __ATOMIC_RELAXED, __HIP_MEMORY_SCOPE_AGENT); }
__device__ __forceinline__ unsigned xb_add(unsigned* p, unsigned v) { return __hip_atomic_fetch_add(p, v, __ATOMIC_RELAXED, __HIP_MEMORY_SCOPE_AGENT); }
__device__ __forceinline__ unsigned xb_xcc_id() { return (unsigned)__builtin_amdgcn_s_getreg((3 << 11) | 20) & 0xFu; }
#define XB_SPIN(cond, bar) do { unsigned _sp = 0; while (cond) { __builtin_amdgcn_s_sleep(1); \
    if ((++_sp & 255u) == 0u) { if (xb_ld(&(bar)[XB_TMO])) break; if (_sp > XB_SPIN_CAP) { atomicAdd(&(bar)[XB_TMO], 1u); break; } } } } while (0)
struct XcdBarrier { unsigned* bar; unsigned x; volatile LAS unsigned* st; };
__device__ __forceinline__ XcdBarrier xcd_barrier_post(unsigned* bar, volatile LAS unsigned* st) {
    XcdBarrier b; b.bar = bar; b.x = xb_xcc_id(); b.st = st;
    if (threadIdx.x == 0) (void)xb_add(&bar[XB_XCNT(b.x)], 1u);
    return b;
}
__device__ __forceinline__ void xcd_barrier_complete(unsigned* bar, unsigned x, unsigned& nloc, unsigned& nx) {
    const unsigned G = gridDim.x * gridDim.y * gridDim.z;
    unsigned sum, cnt, mine, sp = 0u;
    for (;;) {
        sum = 0u; cnt = 0u; mine = 0u;
#pragma unroll
        for (unsigned j = 0; j < 16; ++j) { const unsigned c = xb_ld(&bar[XB_XCNT(j)]); sum += c; cnt += (c > 0u) ? 1u : 0u; mine = (j == x) ? c : mine; }
        if (sum == G) break;
        __builtin_amdgcn_s_sleep(1);
        if ((++sp & 255u) == 0u) { if (xb_ld(&bar[XB_TMO])) break; if (sp > XB_SPIN_CAP) { atomicAdd(&bar[XB_TMO], 1u); break; } }
    }
    nloc = mine > 0u ? mine : 1u; nx = cnt > 0u ? cnt : 1u;
}
__device__ __forceinline__ void xcd_barrier(const XcdBarrier& b) {
    asm volatile("s_waitcnt vmcnt(0)" ::: "memory");
    __syncthreads();
    if (threadIdx.x == 0) {
        unsigned* bar = b.bar;
        __builtin_amdgcn_s_waitcnt(0);
        unsigned nloc = b.st[0], nx = b.st[1];
        if (nloc == 0u) { xcd_barrier_complete(bar, b.x, nloc, nx); b.st[0] = nloc; b.st[1] = nx; }
        const unsigned old = xb_add(&bar[XB_XSUB(b.x)], 1u);
        const unsigned gen = old / nloc;
        if (old + 1u == (gen + 1u) * nloc) {
            __builtin_amdgcn_fence(__ATOMIC_RELEASE, "agent");
            asm volatile("s_waitcnt vmcnt(0)" ::: "memory");
            const unsigned og = xb_add(&bar[XB_TOP], 1u);
            const unsigned tg = og / nx;
            if (og + 1u == (tg + 1u) * nx) xb_add(&bar[XB_TOPGEN], 1u);
            else XB_SPIN(xb_ld(&bar[XB_TOPGEN]) == tg, bar);
            __builtin_amdgcn_fence(__ATOMIC_ACQUIRE, "agent");
            xb_add(&bar[XB_XGEN(b.x)], 1u);
            asm volatile("s_waitcnt vmcnt(0)" ::: "memory");
        } else {
            XB_SPIN(xb_ld(&bar[XB_XGEN(b.x)]) == gen, bar);
            __builtin_amdgcn_fence(__ATOMIC_ACQUIRE, "agent");
            asm volatile("s_waitcnt vmcnt(0)" ::: "memory");
        }
    }
    __syncthreads();
}

constexpr int NWAVES = 8;
enum { I_X = 0, I_MEM, I_POS, I_F1N, I_F1GU, I_F1DN, I_MIXN, I_WIN, I_WPOOL, I_PSCALE, I_QLN, I_KVLN, I_WUQ, I_WUKV, I_QNN, I_KNN, I_QRN, I_KRN,
       I_WBP, I_WBM, I_WOUT, I_XNORM, I_MEMN, I_WXQ, I_WXKV, I_XQN, I_XKN, I_WXO, I_F2N, I_F2GU, I_F2DN, N_IN };
struct Params { const float* in[N_IN]; float* out; unsigned char* ws; int ph_lo, ph_hi; };
static_assert(sizeof(Params) == (N_IN + 2) * 8 + 8, "Params has no padding");


__constant__ float c_inv_freq[32] = {
    1.000000000e+00f, 7.498942018e-01f, 5.623413324e-01f, 4.216965139e-01f, 3.162277639e-01f, 2.371373922e-01f, 1.778279394e-01f, 1.333521456e-01f,
    1.000000015e-01f, 7.498941571e-02f, 5.623412877e-02f, 4.216964915e-02f, 3.162277862e-02f, 2.371373586e-02f, 1.778279431e-02f, 1.333521493e-02f,
    9.999999776e-03f, 7.498942316e-03f, 5.623413250e-03f, 4.216964822e-03f, 3.162277862e-03f, 2.371373819e-03f, 1.778279431e-03f, 1.333521446e-03f,
    1.000000047e-03f, 7.498941850e-04f, 5.623413017e-04f, 4.216965463e-04f, 3.162277862e-04f, 2.371373848e-04f, 1.778279402e-04f, 1.333521504e-04f};

#define LDS_WAIT() asm volatile("s_waitcnt lgkmcnt(0)" ::: "memory")
__device__ __forceinline__ void xcd_skew(int us_per_xcc) {
    if (us_per_xcc <= 0) return;
    const unsigned long long ticks = (unsigned long long)(xb_xcc_id() & 7u) * (unsigned)us_per_xcc * 100ull, t0 = __builtin_amdgcn_s_memrealtime();
    while (__builtin_amdgcn_s_memrealtime() - t0 < ticks) __builtin_amdgcn_s_sleep(4);
}
__device__ __forceinline__ float wave_sum(float v) {
#pragma unroll
    for (int o = 1; o < 64; o <<= 1) v += __shfl_xor(v, o);
    return v;
}
__device__ __forceinline__ unsigned f2bf(float f) { unsigned u = __builtin_bit_cast(unsigned, f); return (u + 0x7fffu + ((u >> 16) & 1u)) >> 16; }
__device__ __forceinline__ unsigned pk2(float lo, float hi) { return f2bf(lo) | (f2bf(hi) << 16); }

template <int MAP> __device__ __forceinline__ int dst_row_of(int n0) {
    if (MAP == 1) { const int isu = n0 >= FF, j = isu ? n0 - FF : n0; return (j >> 7) * 256 + isu * 128 + (j & 127); }
    if (MAP == 2) { if (n0 < 3584) return n0; if (n0 < 3648) return Z_KR + (n0 - 3584); if (n0 < 7744) return Z_GP + (n0 - 3648); return Z_GM + (n0 - 7744); }
    return n0;
}
template <int MAP> __device__ __forceinline__ void transpose_item(const float* W, int K, int N, bf16_t* WT, LAS float* scr, int item, int lane, const float* kgain = nullptr) {
    const int nblk = N / 64, kb = item / nblk, nb = item % nblk, k0 = 64 * kb, n0 = 64 * nb, d0 = dst_row_of<MAP>(n0);
    const int q = lane >> 4, l15 = lane & 15;
    f32x4 v[16];
#pragma unroll
    for (int i = 0; i < 16; ++i) v[i] = __builtin_nontemporal_load((const f32x4*)(W + (size_t)(k0 + 4 * i + q) * N + n0 + l15 * 4));
#pragma unroll
    for (int i = 0; i < 16; ++i) { const float gk = kgain ? kgain[k0 + 4 * i + q] : 1.f; LAS float* s = scr + (4 * i + q) * 65 + l15 * 4; s[0] = v[i].x * gk; s[1] = v[i].y * gk; s[2] = v[i].z * gk; s[3] = v[i].w * gk; }
    LDS_WAIT(); asm volatile("" ::: "memory");
    const int c = lane & 7;
#pragma unroll
    for (int j = 0; j < 8; ++j) { const int n = (lane >> 3) + 8 * j; const LAS float* s = scr + (8 * c) * 65 + n;
        u32x4 o; o.x = cvt_pk_bf16(s[0 * 65], s[1 * 65]); o.y = cvt_pk_bf16(s[2 * 65], s[3 * 65]); o.z = cvt_pk_bf16(s[4 * 65], s[5 * 65]); o.w = cvt_pk_bf16(s[6 * 65], s[7 * 65]);
        *(GAS u32x4*)(WT + (size_t)(d0 + n) * K + k0 + 8 * c) = o; }
    LDS_WAIT(); asm volatile("" ::: "memory");
}
__device__ __forceinline__ void rms_row_4096(const float* xrow, const float* gain, bf16_t* orow, int lane) {
    const f32x4* xr = (const f32x4*)xrow + lane * 2; const f32x4* gr = (const f32x4*)gain + lane * 2;
    f32x4 v[16]; float s = 0.f;
#pragma unroll
    for (int j = 0; j < 8; ++j) { v[2 * j] = xr[128 * j]; v[2 * j + 1] = xr[128 * j + 1];
        s += (v[2 * j].x * v[2 * j].x + v[2 * j].y * v[2 * j].y) + (v[2 * j].z * v[2 * j].z + v[2 * j].w * v[2 * j].w);
        s += (v[2 * j + 1].x * v[2 * j + 1].x + v[2 * j + 1].y * v[2 * j + 1].y) + (v[2 * j + 1].z * v[2 * j + 1].z + v[2 * j + 1].w * v[2 * j + 1].w); }
    const float rstd = rsqrtf(wave_sum(s) * (1.f / 4096.f) + EPS);
    u32x4* o16 = (u32x4*)orow + lane;
#pragma unroll
    for (int j = 0; j < 8; ++j) { const f32x4 g0 = gr[128 * j], g1 = gr[128 * j + 1]; const f32x4 a = v[2 * j] * rstd * g0, b = v[2 * j + 1] * rstd * g1;
        u32x4 w; w.x = cvt_pk_bf16(a.x, a.y); w.y = cvt_pk_bf16(a.z, a.w); w.z = cvt_pk_bf16(b.x, b.y); w.w = cvt_pk_bf16(b.z, b.w); o16[64 * j] = w; }
}
__device__ __forceinline__ void cvt_row_4096(const float* xrow, bf16_t* orow, int lane) {
    const f32x4* xr = (const f32x4*)xrow + lane * 2; u32x4* o16 = (u32x4*)orow + lane; float s = 0.f;
    f32x4 v[16];
#pragma unroll
    for (int j = 0; j < 8; ++j) { v[2 * j] = __builtin_nontemporal_load(xr + 128 * j); v[2 * j + 1] = __builtin_nontemporal_load(xr + 128 * j + 1); }
#pragma unroll
    for (int j = 0; j < 16; ++j) s += (v[j].x * v[j].x + v[j].y * v[j].y) + (v[j].z * v[j].z + v[j].w * v[j].w);
    s = wave_sum(s); const float rs = rsqrtf(s * (1.f / 4096.f) + 1e-6f);
#pragma unroll
    for (int j = 0; j < 8; ++j) { const f32x4 a = v[2 * j] * rs, b = v[2 * j + 1] * rs; u32x4 w; w.x = cvt_pk_bf16(a.x, a.y); w.y = cvt_pk_bf16(a.z, a.w); w.z = cvt_pk_bf16(b.x, b.y); w.w = cvt_pk_bf16(b.z, b.w); o16[64 * j] = w; }
}

#ifndef WGM_DN
#define WGM_DN 2
#endif
#ifndef SKEW_RMW
#define SKEW_RMW 0
#endif
#ifndef PF_DN
#define PF_DN 0
#endif
#ifndef RP_B
#define RP_B 1
#endif
#ifndef RP_C
#define RP_C 1
#endif
#ifndef PROBE_CLK
#define PROBE_CLK -1
#endif
#ifndef PROBE_MODE
#define PROBE_MODE 0
#endif
#ifndef PROBE_MASK
#define PROBE_MASK 0
#endif
#define PROBE_ON(k) ((PROBE_MODE == 0 && PROBE_CLK == (k)) || (PROBE_MODE == 1 && (((PROBE_MASK) >> (k)) & 1)))
#define PROBE2_ON(k) (PROBE_MODE == 2 && (((PROBE_MASK) >> (k)) & 1))
#define PROBE_T0(k) do { if (PROBE2_ON(k) && blockIdx.x == 0 && threadIdx.x == 0) { volatile LAS unsigned long long* pw_ = (volatile LAS unsigned long long*)(LDSP + LDSCTL_OFF); pw_[4] = 1ull; pw_[5] = __builtin_amdgcn_s_memrealtime(); } \
    if (PROBE_ON(k) && blockIdx.x == 0 && threadIdx.x == 0) { volatile LAS unsigned long long* pw_ = (volatile LAS unsigned long long*)(LDSP + LDSCTL_OFF); pw_[0] = __builtin_amdgcn_s_memtime(); pw_[1] = __builtin_amdgcn_s_memrealtime(); } } while (0)
#define PROBE_T1(k) do { if (PROBE2_ON(k) && blockIdx.x == 0 && threadIdx.x == 0) { volatile LAS unsigned long long* pw_ = (volatile LAS unsigned long long*)(LDSP + LDSCTL_OFF); pw_[4] = 0ull; } \
    if (PROBE_ON(k) && blockIdx.x == 0 && threadIdx.x == 0) { volatile LAS unsigned long long* pw_ = (volatile LAS unsigned long long*)(LDSP + LDSCTL_OFF); pw_[2] += __builtin_amdgcn_s_memtime() - pw_[0]; pw_[3] += __builtin_amdgcn_s_memrealtime() - pw_[1]; } } while (0)
constexpr int N_PHASES = 16;

__global__ void __launch_bounds__(NWAVES * 64, 2) mk_fwd(Params P) {
    extern __shared__ __attribute__((aligned(16))) unsigned char lds_raw[];
#define LDSP ((LAS unsigned char*)lds_raw)
#define WSB (P.ws)
    unsigned* ctl = (unsigned*)(WSB + WS_CTL);
    for (int u = threadIdx.x; u < (LDS_BYTES - LDSCTL_OFF) / 4; u += NWAVES * 64) ((LAS unsigned*)(LDSP + LDSCTL_OFF))[u] = 0u;
    __syncthreads();
#if MK_ONE_LAUNCH
    (void)xcd_barrier_post(ctl + CW_BAR, (volatile LAS unsigned*)(LDSP + MISC_OFF) + 8);
#define GRID_BAR() do { XcdBarrier b_; b_.bar = (unsigned*)(WSB + WS_CTL) + CW_BAR; b_.x = xb_xcc_id(); b_.st = (volatile LAS unsigned*)((LAS unsigned char*)lds_raw + MISC_OFF) + 8; xcd_barrier(b_); } while (0)
    constexpr int lo = 0, hi = N_PHASES;
#else
#define GRID_BAR() do { } while (0)
    const int lo = P.ph_lo, hi = P.ph_hi;
#endif
#ifndef MK_PHASES
#define MK_PHASES 0xffff
#endif
#define IN(k) ((((MK_PHASES) >> (k)) & 1) && lo <= (k) && (k) < hi)
#define SEAM(k) do { if (IN(k) && IN((k) + 1)) GRID_BAR(); } while (0)
#define PHASE_IDS() int tid_ = threadIdx.x; asm volatile("" : "+v"(tid_)); const int lane = tid_ & 63, wave_ = __builtin_amdgcn_readfirstlane(tid_ >> 6); \
    const int G_ = gridDim.x, vcu_ = (G_ % 8 == 0) ? ((int)blockIdx.x % 8) * (G_ / 8) + (int)blockIdx.x / 8 : (int)blockIdx.x, gw = vcu_ * NWAVES + wave_, NGW = G_ * NWAVES; (void)gw; (void)NGW; (void)lane; (void)vcu_; (void)wave_

#define WGU ((bf16_t*)(WSB + WS_WGU))
#define WDN ((bf16_t*)(WSB + WS_WDN))
#define WIN ((bf16_t*)(WSB + WS_WIN))
#define WPOOL ((bf16_t*)(WSB + WS_WPOOL))
#define WUQ ((bf16_t*)(WSB + WS_WUQ))
#define WUKV ((bf16_t*)(WSB + WS_WUKV))
#define WBP ((bf16_t*)(WSB + WS_WBP))
#define WBM ((bf16_t*)(WSB + WS_WBM))
#define WOUT ((bf16_t*)(WSB + WS_WOUT))
#define WXQ ((bf16_t*)(WSB + WS_WXQ))
#define WXKV ((bf16_t*)(WSB + WS_WXKV))
#define WXO ((bf16_t*)(WSB + WS_WXO))
#define XN ((bf16_t*)(WSB + WS_XN))
#define MN ((bf16_t*)(WSB + WS_MN))
#define XKV ((float*)(WSB + WS_XKV))
#define XKB ((bf16_t*)(WSB + WS_XKB))
#define XVB ((bf16_t*)(WSB + WS_XVB))
#define HID ((bf16_t*)(WSB + WS_HID))
#define Z ((bf16_t*)(WSB + WS_Z))
#define CQ ((bf16_t*)(WSB + WS_CQ))
#define CKV ((bf16_t*)(WSB + WS_CKV))
#define KR ((bf16_t*)(WSB + WS_KR))
#define CSTAB ((float*)(WSB + WS_CS))
#define GQ8 ((unsigned char*)(WSB + WS_GQ))
#define PM ((bf16_t*)(WSB + WS_PM))
#define QB ((bf16_t*)(WSB + WS_Q))
#define KVB ((bf16_t*)(WSB + WS_KV))
#define AO ((bf16_t*)(WSB + WS_AO))
#define BO ((bf16_t*)(WSB + WS_BO))
#define MG ((bf16_t*)(WSB + WS_R + 376 * MiB))
#define XQP ((float*)(WSB + WS_XQP))
#define XO ((bf16_t*)(WSB + WS_XO))
#define SS0 ((float*)(WSB + WS_SS))
#define SS1 ((float*)(WSB + WS_SS) + M)
#define SS2 ((float*)(WSB + WS_SS) + 2 * M)
#define SSX ((float*)(WSB + WS_SS) + 3 * M)
#define OUT (P.out)

#define TRANSPOSE_JOB(MAP, SRC, KK, NN, DST, KG) { const int nit = ((KK) / 64) * ((NN) / 64); if (r < nit) { transpose_item<MAP>((SRC), (KK), (NN), (DST), scr, r, lane, (KG)); continue; } r -= nit; }

#if RP_C > 1
    for (int rep_ = 0; rep_ < RP_C; ++rep_) { if (rep_) GRID_BAR();
#endif
    PROBE_T0(0);
    if (IN(0)) {
        PHASE_IDS();
        LAS float* scr = (LAS float*)(LDSP + wave_ * 16896);
        constexpr int TOT = (D / 64) * (2 * FF / 64) + (FF / 64) * (D / 64) + (D / 64) * (11840 / 64) + (2048 / 64) * (512 / 64) + (1024 / 64) * (3072 / 64) + (512 / 64) * (4096 / 64)
                          + 2 * (2048 / 64) * (4096 / 64) + (4096 / 64) * (4096 / 64) + (4096 / 64) * (512 / 64) + (4096 / 64) * (1024 / 64) + (512 / 64) * (4096 / 64);
        for (int it = gw; it < TOT; it += NGW) {
            int r = it;
            TRANSPOSE_JOB(1, P.in[I_F1GU], D, 2 * FF, WGU, P.in[I_F1N])
            TRANSPOSE_JOB(0, P.in[I_F1DN], FF, D, WDN, nullptr)
            TRANSPOSE_JOB(2, P.in[I_WIN], D, 11840, WIN, P.in[I_MIXN])
            TRANSPOSE_JOB(0, P.in[I_WPOOL], 2048, 512, WPOOL, nullptr)
            TRANSPOSE_JOB(0, P.in[I_WUQ], 1024, 3072, WUQ, nullptr)
            TRANSPOSE_JOB(0, P.in[I_WUKV], 512, 4096, WUKV, nullptr)
            TRANSPOSE_JOB(0, P.in[I_WBP], 2048, 4096, WBP, nullptr)
            TRANSPOSE_JOB(0, P.in[I_WBM], 2048, 4096, WBM, nullptr)
            TRANSPOSE_JOB(0, P.in[I_WOUT], 4096, 4096, WOUT, nullptr)
            TRANSPOSE_JOB(0, P.in[I_WXQ], 4096, 512, WXQ, P.in[I_XNORM])
            TRANSPOSE_JOB(0, P.in[I_WXKV], 4096, 1024, WXKV, nullptr)
            TRANSPOSE_JOB(0, P.in[I_WXO], 512, 4096, WXO, nullptr)
        }
        { u32x4* zp = (u32x4*)(WIN + (size_t)11840 * D); const int n16 = 192 * D * 2 / 16; for (int i = gw * 64 + lane; i < n16; i += NGW * 64) zp[i] = (u32x4){0u, 0u, 0u, 0u}; }
        for (int m = gw; m < M; m += NGW) cvt_row_4096(P.in[I_X] + (size_t)m * D, XN + (size_t)m * D, lane);
        for (int m = gw; m < MMEM; m += NGW) rms_row_4096(P.in[I_MEM] + (size_t)m * D, P.in[I_MEMN], MN + (size_t)m * D, lane);
    }
#if RP_C > 1
    }
#endif
    PROBE_T1(0);
    SEAM(0);
#if RP_A > 1
    for (int rep_ = 0; rep_ < RP_A; ++rep_) { if (rep_) GRID_BAR();
#else
    constexpr int rep_ = 0;
#endif
    PROBE_T0(1);
    if (IN(1)) {
        pg8::Gemm g = pg8::mk_gemm(XN, WGU, D, D, D); pg8::StaticOrder S; S.init(M / 256, FF / 128, (int)gridDim.x, (int)blockIdx.x);
        pg8::EpiSwiGLU<false> E{HID, FF, nullptr};
        pg8::gemm_phase(LDSP, g, S, E);
    }
    PROBE_T1(1);
    SEAM(1);
    PROBE_T0(2);
    if (IN(2)) {
        xcd_skew(SKEW_RMW); pg8::Gemm g = pg8::mk_gemm(HID, WDN, FF, FF, FF); pg8::StaticOrder S; S.init(M / 256, D / 256, (int)gridDim.x, (int)blockIdx.x, WGM_DN);
        pg8::EpiResH<0> E{P.in[I_X], XN, nullptr, D, 0.5f, SS0};
        pg8::gemm_phase<pg8::EpiResH<0>, pg8::StaticOrder, PF_DN>(LDSP, g, S, E);
    }
#if RP_A > 1
    }
#endif
    PROBE_T1(2);
    SEAM(2);
    PROBE_T0(3);
    if (IN(3)) {
        { pg8::Gemm g = pg8::mk_gemm(XN, WIN, D, D, D); pg8::StaticOrder S; S.init(M / 256, ZW / 256, (int)gridDim.x, (int)blockIdx.x);
          pg8::EpiWin E{Z, ZW, GQ8, (size_t)M * 4096, SS0};
          pg8::gemm_phase(LDSP, g, S, E); }
        { pg8::Gemm g = pg8::mk_gemm(MN, WXKV, D, D, D); pg8::StaticOrder S; S.init(MMEM / 256, 1024 / 256, (int)gridDim.x, (int)((blockIdx.x + 64u) % (unsigned)(int)gridDim.x));
          pg8::EpiF32Split E{XKV, 1024, 0x7fffffff, 30, 0, nullptr};
          pg8::gemm_phase(LDSP, g, S, E); }
    }
    PROBE_T1(3);
    SEAM(3);
#if RP_D > 1
    for (int repd_ = 0; repd_ < RP_D; ++repd_) { if (repd_) GRID_BAR();
#endif
    PROBE_T0(4);
    if (IN(4)) {
        PHASE_IDS();
        const float* gq = P.in[I_QLN]; const float* gkv = P.in[I_KVLN]; const float* gkr = P.in[I_KRN]; const int* pos = (const int*)P.in[I_POS];
        for (int m = gw; m < M; m += NGW) {
            const bf16_t* zr = Z + (size_t)m * ZW; const int t = m & (SEQ - 1);
            const u32x4 zq0 = *(const u32x4*)(zr + Z_ZQ + lane * 8), zq1 = *(const u32x4*)(zr + Z_ZQ + 512 + lane * 8), zkv = *(const u32x4*)(zr + Z_ZKV + lane * 8);
            const unsigned zkr = (unsigned)zr[Z_KR + lane]; const int posm = pos[m];
            u32x4 pown[4], pnb[29];
#pragma unroll
            for (int g = 0; g < 4; ++g) pown[g] = *(const u32x4*)(zr + Z_ZP + g * 512 + lane * 8);
            const bool fullw = t >= 15;
            if (fullw) {
#pragma unroll
                for (int g = 0; g < 4; ++g)
#pragma unroll
                    for (int j = 1; j < (2 << g); ++j) pnb[(2 << g) - 2 + j - 1] = *(const u32x4*)(zr - (size_t)j * ZW + Z_ZP + g * 512 + lane * 8);
            }
            asm volatile("" ::: "memory");
            {
                float a[8], b[8]; unpack8(zq0, a); unpack8(zq1, b);
                float s = 0.f;
#pragma unroll
                for (int e = 0; e < 8; ++e) s += a[e] * a[e] + b[e] * b[e];
                const float rstd = rsqrtf(wave_sum(s) * (1.f / 1024.f) + EPS);
#pragma unroll
                for (int e = 0; e < 8; ++e) { a[e] *= rstd * gq[lane * 8 + e]; b[e] *= rstd * gq[512 + lane * 8 + e]; }
                *(u32x4*)(CQ + (size_t)m * 1024 + lane * 8) = pack8(a); *(u32x4*)(CQ + (size_t)m * 1024 + 512 + lane * 8) = pack8(b); }
            {
                float a[8]; unpack8(zkv, a);
                float s = 0.f;
#pragma unroll
                for (int e = 0; e < 8; ++e) s += a[e] * a[e];
                const float rstd = rsqrtf(wave_sum(s) * (1.f / 512.f) + EPS);
#pragma unroll
                for (int e = 0; e < 8; ++e) a[e] *= rstd * gkv[lane * 8 + e];
                *(u32x4*)(CKV + (size_t)m * 512 + lane * 8) = pack8(a); }
            {
                const float x = bf_lo(zkr);
                const float rstd = rsqrtf(wave_sum(x * x) * (1.f / 64.f) + EPS);
                const float y = x * rstd * gkr[lane], yp = __shfl_xor(y, 32);
                const float ang = (float)posm * c_inv_freq[lane & 31], cs = cosf(ang), sn = sinf(ang);
                const float o = (lane < 32) ? (y * cs - yp * sn) : (y * cs + yp * sn);
                KR[(size_t)m * 64 + lane] = (bf16_t)f2bf(o);
                CSTAB[(size_t)m * 64 + lane] = (lane < 32) ? cs : sn; }
            {
#pragma unroll
                for (int g = 0; g < 4; ++g) { const int w = 2 << g; float acc[8], own[8];
                    unpack8(pown[g], own);
#pragma unroll
                    for (int e = 0; e < 8; ++e) acc[e] = own[e];
                    const int nb = t < (w - 1) ? t : (w - 1);
                    if (fullw) {
#pragma unroll
                        for (int j = 1; j < w; ++j) { float v[8]; unpack8(pnb[w - 2 + j - 1], v);
#pragma unroll
                            for (int e = 0; e < 8; ++e) acc[e] += v[e]; }
                    } else {
                        for (int j = 1; j <= nb; ++j) { float v[8]; unpack8(*(const u32x4*)(zr - (size_t)j * ZW + Z_ZP + g * 512 + lane * 8), v);
#pragma unroll
                            for (int e = 0; e < 8; ++e) acc[e] += v[e]; } }
                    const float inv = 1.0f / (float)(nb + 1);
#pragma unroll
                    for (int e = 0; e < 8; ++e) acc[e] = acc[e] * inv - own[e];
                    *(u32x4*)(PM + (size_t)m * 2048 + g * 512 + lane * 8) = pack8(acc); } }
        }
        {
            const float* gxk = P.in[I_XKN];
            for (int m = gw; m < MMEM; m += NGW) {
                const float* kr = XKV + (size_t)m * 1024 + lane * 8; const float* vr = kr + 512;
                const f32x4 k0 = *(const f32x4*)kr, k1 = *(const f32x4*)(kr + 4), v0 = *(const f32x4*)vr, v1 = *(const f32x4*)(vr + 4);
                float s = (k0.x * k0.x + k0.y * k0.y) + (k0.z * k0.z + k0.w * k0.w) + (k1.x * k1.x + k1.y * k1.y) + (k1.z * k1.z + k1.w * k1.w);
                s += __shfl_xor(s, 1); s += __shfl_xor(s, 2); s += __shfl_xor(s, 4); s += __shfl_xor(s, 8);
                const float rstd = rsqrtf(s * (1.f / 128.f) + EPS); const int c = (lane & 15) * 8;
                float a[8] = {k0.x * rstd * gxk[c], k0.y * rstd * gxk[c + 1], k0.z * rstd * gxk[c + 2], k0.w * rstd * gxk[c + 3], k1.x * rstd * gxk[c + 4], k1.y * rstd * gxk[c + 5], k1.z * rstd * gxk[c + 6], k1.w * rstd * gxk[c + 7]};
                float bb[8] = {v0.x, v0.y, v0.z, v0.w, v1.x, v1.y, v1.z, v1.w};
                *(u32x4*)(XKB + (size_t)m * 512 + lane * 8) = pack8(a); *(u32x4*)(XVB + (size_t)m * 512 + lane * 8) = pack8(bb);
            } }
        {
            LAS float* scr = (LAS float*)(LDSP + wave_ * 16896);
            constexpr int TOT = (D / 64) * (2 * FF / 64) + (FF / 64) * (D / 64);
            for (int it = gw; it < TOT; it += NGW) {
                int r = it;
                TRANSPOSE_JOB(1, P.in[I_F2GU], D, 2 * FF, WGU, P.in[I_F2N])
                TRANSPOSE_JOB(0, P.in[I_F2DN], FF, D, WDN, nullptr)
            } }
    }
#if RP_D > 1
    }
#endif
    PROBE_T1(4);
    SEAM(4);
    PROBE_T0(5);
    if (IN(5)) {
        { pg8::Gemm g = pg8::mk_gemm(CQ, WUQ, 1024, 1024, 1024); pg8::StaticOrder S; S.init(M / 256, QW / 256, (int)gridDim.x, (int)blockIdx.x);
          pg8::EpiBf16S<false> E{QB, QW, nullptr}; pg8::gemm_phase(LDSP, g, S, E); }
        { pg8::Gemm g = pg8::mk_gemm(CKV, WUKV, 512, 512, 512); pg8::StaticOrder S; S.init(M / 256, KVW / 256, (int)gridDim.x, (int)blockIdx.x);
          pg8::EpiKV E{KVB, KVW, P.in[I_KNN], (LAS float*)(LDSP + RING_BYTES)}; pg8::gemm_phase(LDSP, g, S, E); }
        { pg8::Gemm g = pg8::mk_gemm(PM, WPOOL, 2048, 2048, 512); g.ashift = 1; g.astride = 512; g.bmask = 1; g.bstride = 512;
          pg8::StaticOrder S; S.init(M / 256, AW / 256, (int)gridDim.x, (int)blockIdx.x);
          pg8::EpiBf16S<true> E{AO, AW, P.in[I_PSCALE]}; pg8::gemm_phase(LDSP, g, S, E); }
    }
    PROBE_T1(5);
    SEAM(5);
    PROBE_T0(6);
    PROBE_T1(6);
#if RP_B > 1
    for (int rep_ = 0; rep_ < RP_B; ++rep_) { if (rep_) GRID_BAR();
#endif
    PROBE_T0(7);
    if (IN(7)) {
        PHASE_IDS();
        const int r32 = lane & 31, hi5 = lane >> 5;
        for (int item = vcu_; item < 512; item += (int)gridDim.x) {
            const int bh = item >> 4, x = item & 15, b = bh >> 4, h = bh & 15;
#pragma unroll 1
            for (int half = 0; half < 2; ++half) {
                const int qb = half ? x : 31 - x;
                const size_t row0 = (size_t)b * SEQ + (size_t)qb * 256;
                bf16x8 qr[12];
                int t3 = threadIdx.x; asm volatile("" : "+v"(t3));
                { const int hq = (t3 >> 5) & 1; const size_t qrow = row0 + (t3 >> 6) * 32 + (t3 & 31);
                  const bf16_t* Qw = QB + qrow * QW + h * 192 + hq * 8;
                  float x[12][8]; float sn_ = 0.f, sr_ = 0.f;
#pragma unroll
                  for (int d0 = 0; d0 < 12; ++d0) { unpack8(*(const u32x4*)(Qw + d0 * 16), x[d0]);
#pragma unroll
                      for (int j = 0; j < 8; ++j) { if (d0 < 8) sn_ += x[d0][j] * x[d0][j]; else sr_ += x[d0][j] * x[d0][j]; } }
                  sn_ = xsum32(sn_); sr_ = xsum32(sr_);
                  const float rn = rsqrtf(sn_ * (1.f / 128.f) + EPS) * QSCALE, rr = rsqrtf(sr_ * (1.f / 64.f) + EPS);
                  const float* gqn = P.in[I_QNN] + hq * 8; const float* gqr = P.in[I_QRN] + hq * 8; const float* cst = CSTAB + qrow * 64 + hq * 8;
#pragma unroll
                  for (int d0 = 0; d0 < 8; ++d0) { const f32x4 g0 = *(const f32x4*)(gqn + d0 * 16), g1 = *(const f32x4*)(gqn + d0 * 16 + 4);
                      float y[8] = {x[d0][0] * rn * g0.x, x[d0][1] * rn * g0.y, x[d0][2] * rn * g0.z, x[d0][3] * rn * g0.w, x[d0][4] * rn * g1.x, x[d0][5] * rn * g1.y, x[d0][6] * rn * g1.z, x[d0][7] * rn * g1.w};
                      qr[d0] = __builtin_bit_cast(bf16x8, pack8(y)); }
#pragma unroll
                  for (int dd = 0; dd < 2; ++dd) {
                      const f32x4 ga0 = *(const f32x4*)(gqr + dd * 16), ga1 = *(const f32x4*)(gqr + dd * 16 + 4), gb0 = *(const f32x4*)(gqr + 32 + dd * 16), gb1 = *(const f32x4*)(gqr + 32 + dd * 16 + 4);
                      const f32x4 c0 = *(const f32x4*)(cst + dd * 16), c1 = *(const f32x4*)(cst + dd * 16 + 4), s0 = *(const f32x4*)(cst + 32 + dd * 16), s1 = *(const f32x4*)(cst + 32 + dd * 16 + 4);
                      const float ga[8] = {ga0.x, ga0.y, ga0.z, ga0.w, ga1.x, ga1.y, ga1.z, ga1.w}, gb[8] = {gb0.x, gb0.y, gb0.z, gb0.w, gb1.x, gb1.y, gb1.z, gb1.w};
                      const float cc[8] = {c0.x, c0.y, c0.z, c0.w, c1.x, c1.y, c1.z, c1.w}, ss[8] = {s0.x, s0.y, s0.z, s0.w, s1.x, s1.y, s1.z, s1.w};
                      float ya[8], yb[8];
#pragma unroll
                      for (int j = 0; j < 8; ++j) { const float a = x[8 + dd][j] * rr * ga[j], bq = x[10 + dd][j] * rr * gb[j];
                          ya[j] = (a * cc[j] - bq * ss[j]) * QSCALE; yb[j] = (bq * cc[j] + a * ss[j]) * QSCALE; }
                      qr[8 + dd] = __builtin_bit_cast(bf16x8, pack8(ya)); qr[10 + dd] = __builtin_bit_cast(bf16x8, pack8(yb)); } }
                att::attn_unit_pp<192, true>(qr, KVB + (size_t)b * SEQ * KVW + h * 256, KVW, KR + (size_t)b * SEQ * 64, 64, KVB + (size_t)b * SEQ * KVW + h * 256 + 128, KVW,
                                          BO + row0 * AW + h * 128, AW, 4 * (qb + 1), (char*)lds_raw);
            }
        }
    }
#if RP_B > 1
    }
#endif
    PROBE_T1(7);
    SEAM(7);
    PROBE_T0(8);
    PROBE_T1(8);
    PROBE_T0(9);
    if (IN(9)) {
        pg8::Gemm g = pg8::mk_gemm(AO, WBP, AW, AW, AW); g.A2 = BO; g.Bt2 = WBM;
        pg8::TwoSegOrder S; S.init(M / 256, D / 256, (int)gridDim.x, (int)blockIdx.x);
        pg8::EpiMerge2 E{MG, D, GQ8, (size_t)M * 4096}; pg8::gemm_phase(LDSP, g, S, E);
    }
    PROBE_T1(9);
    SEAM(9);
    PROBE_T0(10);
    if (IN(10)) {
        xcd_skew(SKEW_RMW); pg8::Gemm g = pg8::mk_gemm(MG, WOUT, D, D, D); pg8::StaticOrder S; S.init(M / 256, D / 256, (int)gridDim.x, (int)blockIdx.x);
        pg8::EpiResH<1> E{nullptr, XN, nullptr, D, 1.0f, SS1}; pg8::gemm_phase(LDSP, g, S, E);
    }
    PROBE_T1(10);
    SEAM(10);
    PROBE_T0(11);
    if (IN(11)) {
        pg8::Gemm g = pg8::mk_gemm(XN, WXQ, D, D, 2048); g.ashift = 1; g.astride = 2048; g.bmask = 1; g.bstride = 2048;
        pg8::StaticOrder S; S.init(M / 256, 4, (int)gridDim.x, (int)blockIdx.x);
        pg8::EpiF32Split E{XQP, 512, 1, 1, (size_t)M * 512, SS1}; pg8::gemm_phase(LDSP, g, S, E);
    }
    PROBE_T1(11);
    SEAM(11);
    PROBE_T0(12);
    if (IN(12)) {
        PHASE_IDS();
        const int r32 = lane & 31, hi5 = lane >> 5; const float* gxq = P.in[I_XQN];
        for (int item = vcu_; item < 256; item += (int)gridDim.x) {
            const int bh = item >> 5, qb = item & 31, b = bh >> 2, h = bh & 3;
            const size_t row0 = (size_t)b * SEQ + (size_t)qb * 256;
            bf16x8 qr[8];
            { const float* q0 = XQP + (row0 + wave_ * 32 + r32) * 512 + h * 128 + hi5 * 8; const float* q1 = q0 + (size_t)M * 512;
              f32x4 qa[8], qbv[8]; float s = 0.f;
#pragma unroll
              for (int d0 = 0; d0 < 8; ++d0) { qa[d0] = *(const f32x4*)(q0 + d0 * 16) + *(const f32x4*)(q1 + d0 * 16); qbv[d0] = *(const f32x4*)(q0 + d0 * 16 + 4) + *(const f32x4*)(q1 + d0 * 16 + 4);
                  s += (qa[d0].x * qa[d0].x + qa[d0].y * qa[d0].y) + (qa[d0].z * qa[d0].z + qa[d0].w * qa[d0].w) + (qbv[d0].x * qbv[d0].x + qbv[d0].y * qbv[d0].y) + (qbv[d0].z * qbv[d0].z + qbv[d0].w * qbv[d0].w); }
              s = xsum32(s);
              const float rstd = rsqrtf(s * (1.f / 128.f) + EPS) * XSCALE;
#pragma unroll
              for (int d0 = 0; d0 < 8; ++d0) { const float* gp = gxq + d0 * 16 + hi5 * 8; const f32x4 g0 = *(const f32x4*)gp, g1 = *(const f32x4*)(gp + 4);
                  const f32x4 a = qa[d0] * rstd * g0, c = qbv[d0] * rstd * g1; u32x4 w; w.x = cvt_pk_bf16(a.x, a.y); w.y = cvt_pk_bf16(a.z, a.w); w.z = cvt_pk_bf16(c.x, c.y); w.w = cvt_pk_bf16(c.z, c.w);
                  qr[d0] = __builtin_bit_cast(bf16x8, w); } }
            att::attn_unit<128, false>(qr, XKB + (size_t)b * 256 * 512 + h * 128, 512, nullptr, 0, XVB + (size_t)b * 256 * 512 + h * 128, 512,
                                       XO + row0 * 512 + h * 128, 512, 4, (char*)lds_raw);
        }
    }
    PROBE_T1(12);
    SEAM(12);
    PROBE_T0(13);
    if (IN(13)) {
        xcd_skew(SKEW_RMW); pg8::Gemm g = pg8::mk_gemm(XO, WXO, 512, 512, 512); pg8::StaticOrder S; S.init(M / 256, D / 256, (int)gridDim.x, (int)blockIdx.x);
        pg8::EpiResH<1> E{nullptr, XN, nullptr, D, 1.0f, SS2}; pg8::gemm_phase(LDSP, g, S, E);
    }
    PROBE_T1(13);
    SEAM(13);
    PROBE_T0(14);
    if (IN(14)) {
        pg8::Gemm g = pg8::mk_gemm(XN, WGU, D, D, D); pg8::StaticOrder S; S.init(M / 256, FF / 128, (int)gridDim.x, (int)blockIdx.x);
        pg8::EpiSwiGLU<true> E{HID, FF, SS2}; pg8::gemm_phase(LDSP, g, S, E);
    }
    PROBE_T1(14);
    SEAM(14);
    PROBE_T0(15);
    if (IN(15)) {
        xcd_skew(SKEW_RMW); pg8::Gemm g = pg8::mk_gemm(HID, WDN, FF, FF, FF); pg8::StaticOrder S; S.init(M / 256, D / 256, (int)gridDim.x, (int)blockIdx.x, WGM_DN);
        pg8::EpiResH<2> E{nullptr, XN, OUT, D, 0.5f, nullptr}; pg8::gemm_phase<pg8::EpiResH<2>, pg8::StaticOrder, PF_DN>(LDSP, g, S, E);
    }
    PROBE_T1(15);
    if ((PROBE_CLK >= 0 || PROBE_MODE >= 1) && blockIdx.x == 0 && threadIdx.x == 0) {
        volatile LAS unsigned long long* pw_ = (volatile LAS unsigned long long*)(LDSP + LDSCTL_OFF);
        const unsigned long long dc = pw_[2], dr = pw_[3];
        const unsigned long long ticks = PROBE_MODE ? dr : (dc * 5000ull) / (dr ? dr : 1ull);
        const unsigned long long t0 = __builtin_amdgcn_s_memrealtime();
        while (__builtin_amdgcn_s_memrealtime() - t0 < ticks) __builtin_amdgcn_s_sleep(8);
    }
#undef IN
#undef SEAM
#undef TRANSPOSE_JOB
}

extern "C" void kernel_launch(void* const* d_in, const int* in_sizes, int n_in, void* d_out, int out_size, void* d_ws, size_t ws_size, hipStream_t stream) {
    static int grid = 0;
    if (grid == 0) {
        if (n_in != N_IN || in_sizes[0] != M * D || out_size != M * D || ws_size < WS_END) {
            fprintf(stderr, "kernel_launch: unexpected shapes: n_in %d in0 %d out %d ws %zu (need %zu)\n", n_in, n_in > 0 ? in_sizes[0] : -1, out_size, ws_size, (size_t)WS_END); grid = -1; return; }
        int dev = 0, cus = 0;
        if (hipGetDevice(&dev) != hipSuccess || hipDeviceGetAttribute(&cus, hipDeviceAttributeMultiprocessorCount, dev) != hipSuccess) { grid = -1; return; }
        if (hipFuncSetAttribute((const void*)mk_fwd, hipFuncAttributeMaxDynamicSharedMemorySize, LDS_BYTES) != hipSuccess) { fprintf(stderr, "kernel_launch: hipFuncSetAttribute failed\n"); grid = -1; return; }
        int per_cu = 0;
        if (hipOccupancyMaxActiveBlocksPerMultiprocessor(&per_cu, (const void*)mk_fwd, NWAVES * 64, LDS_BYTES) != hipSuccess || per_cu < 1) { fprintf(stderr, "kernel_launch: occupancy query says %d\n", per_cu); }
        (void)hipGetLastError();
        grid = cus;
    }
    if (grid < 0) return;
    (void)hipMemsetAsync((char*)d_ws + WS_CTL, 0, CTL_ZERO_BYTES, stream);
    Params p{};
    for (int i = 0; i < N_IN; ++i) p.in[i] = (const float*)d_in[i];
    p.out = (float*)d_out; p.ws = (unsigned char*)d_ws;
#if MK_ONE_LAUNCH
    p.ph_lo = 0; p.ph_hi = N_PHASES;
    hipLaunchKernelGGL(mk_fwd, dim3(grid), dim3(NWAVES * 64), LDS_BYTES, stream, p);
#else
    for (int k = 0; k < N_PHASES; ++k) { p.ph_lo = k; p.ph_hi = k + 1; hipLaunchKernelGGL(mk_fwd, dim3(grid), dim3(NWAVES * 64), LDS_BYTES, stream, p); }
#endif
    const hipError_t le = hipPeekAtLastError();
    if (le != hipSuccess) fprintf(stderr, "kernel_launch: launch failed: %s\n", hipGetErrorName(le));
}
```
